# Optimizing an MI355X kernel written in HIP

```python
import math, functools
import jax, jax.numpy as jnp
from jax import lax
import numpy as np

D_MODEL = 1024
BATCH = 1
SEQ = 16384
DEPTH = 2

GRID_W = 64
CTX_LEN = 256
HEAD_DIM = 64
RET_HEADS = 4
HG_HEADS = 4
ATT_Q_HEADS = 4
ATT_KV_HEADS = 2
GDN_HEADS = 4
BRANCH_W = 4 * HEAD_DIM
N_BRANCHES = 4
RET_CHUNK = 128
HG_CHUNK = 64
GDN_CHUNK = 64
ATT_BLOCK = 128
ROPE_THETA = 10000.0
ROPE_AXIS_DIM = HEAD_DIM // 2
CONV_W = 3
N_EXPERTS = 16
EXPERT_FF = 1024
CAPACITY_FACTOR = 2
EPS = 1e-6
F32 = jnp.float32

IN_SPLITS = (
    ('ret_q', RET_HEADS * HEAD_DIM), ('ret_k', RET_HEADS * HEAD_DIM), ('ret_v', RET_HEADS * HEAD_DIM),
    ('ret_g', RET_HEADS * HEAD_DIM),
    ('hg_q', HG_HEADS * HEAD_DIM), ('hg_f_fwd', HG_HEADS * HEAD_DIM), ('hg_f_bwd', HG_HEADS * HEAD_DIM),
    ('hg_i', HG_HEADS * HEAD_DIM), ('hg_g', HG_HEADS * HEAD_DIM),
    ('at_q', ATT_Q_HEADS * HEAD_DIM), ('at_k', ATT_KV_HEADS * HEAD_DIM), ('at_v', ATT_KV_HEADS * HEAD_DIM),
    ('gd_q', GDN_HEADS * HEAD_DIM), ('gd_k', GDN_HEADS * HEAD_DIM), ('gd_v', GDN_HEADS * HEAD_DIM),
    ('gd_a_fwd', GDN_HEADS), ('gd_a_bwd', GDN_HEADS), ('gd_b_fwd', GDN_HEADS), ('gd_b_bwd', GDN_HEADS),
    ('gd_g', GDN_HEADS * HEAD_DIM),
)
D_IN = sum(width for _, width in IN_SPLITS)

kernel_name = 'hybrid_quad_mixer_ec_moe'


def rmsnorm(x, g):
    x32 = x.astype(F32)
    y = x32 * lax.rsqrt(jnp.mean(x32 * x32, axis=-1, keepdims=True) + EPS)
    return (y * g.astype(F32)).astype(x.dtype)


def l2norm(x):
    return x * lax.rsqrt(jnp.sum(x * x, axis=-1, keepdims=True) + EPS)


def modulate(h, shift, scale):
    return h * (1 + scale) + shift


def to_heads(z, n_heads):
    b, l, _ = z.shape
    return z.reshape(b, l, n_heads, -1).transpose(0, 2, 1, 3).astype(F32)


def head_norm_gate(o, g, gate):
    b, h, l, d = o.shape
    o = rmsnorm(o.transpose(0, 2, 1, 3), g).reshape(b, l, h * d)
    return o.astype(gate.dtype) * jax.nn.silu(gate)


def split_cols(z):
    out, start = {}, 0
    for name, width in IN_SPLITS:
        out[name] = z[..., start:start + width]
        start += width
    return out


def axial_rope_tables(n_tokens):
    rows = n_tokens // GRID_W
    row = jnp.repeat(jnp.arange(rows, dtype=F32), GRID_W)
    col = jnp.tile(jnp.arange(GRID_W, dtype=F32), rows)
    inv_freq = ROPE_THETA ** (-jnp.arange(0, ROPE_AXIS_DIM, 2, dtype=F32) / ROPE_AXIS_DIM)
    ang = jnp.stack([row[:, None] * inv_freq, col[:, None] * inv_freq], axis=1)
    return jnp.cos(ang), jnp.sin(ang)


def apply_rope(x, cos, sin):
    half = ROPE_AXIS_DIM // 2
    xr = x.astype(F32).reshape(x.shape[:-1] + (2, 2, half))
    x1, x2 = xr[..., 0, :], xr[..., 1, :]
    c, s = cos[None, :, None], sin[None, :, None]
    out = jnp.stack([x1 * c - x2 * s, x2 * c + x1 * s], axis=-2)
    return out.reshape(x.shape).astype(x.dtype)


def dwconv_centred(x, w):
    ch = x.shape[-1]
    return lax.conv_general_dilated(x, w[:, None, :].astype(x.dtype), window_strides=(1,),
                                    padding=[(CONV_W // 2, CONV_W // 2)],
                                    dimension_numbers=('NWC', 'WIO', 'NWC'), feature_group_count=ch)


def chunk_states(chunk_decay, ds, s0):
    chunk_decay = jnp.broadcast_to(chunk_decay, ds.shape[:4] + (1,))

    def step(s, inp):
        a, d = inp
        return a * s + d, s

    s_final, s_start = lax.scan(step, s0, (jnp.moveaxis(chunk_decay, 2, 0), jnp.moveaxis(ds, 2, 0)))
    return jnp.moveaxis(s_start, 0, 2), s_final


def retention_chunked(q, k, v, s0, need_out, log_gamma):
    b, h, l, dk = q.shape
    dv = v.shape[-1]
    n = l // RET_CHUNK
    q = q.reshape(b, h, n, RET_CHUNK, dk)
    k = k.reshape(b, h, n, RET_CHUNK, dk)
    v = v.reshape(b, h, n, RET_CHUNK, dv)
    pos = jnp.arange(RET_CHUNK, dtype=F32)
    lg = log_gamma.astype(F32)[:, None]
    k_dec = jnp.exp(lg * (RET_CHUNK - 1 - pos))[None, :, None, :, None]
    ds = jnp.einsum('bhnsd,bhnsv->bhndv', k * k_dec, v)
    s_start, s_final = chunk_states(jnp.exp(lg * RET_CHUNK)[None, :, None, :, None], ds, s0)
    if not need_out:
        return None, s_final
    rel = pos[:, None] - pos[None, :]
    dmat = jnp.where(rel >= 0, jnp.exp(lg[:, :, None] * jnp.maximum(rel, 0.0)), 0.0)
    scores = jnp.einsum('bhntd,bhnsd->bhnts', q, k) * dmat[None, :, None]
    q_dec = jnp.exp(lg * (pos + 1))[None, :, None, :, None]
    o = jnp.einsum('bhnts,bhnsv->bhntv', scores, v) + jnp.einsum('bhntd,bhndv->bhntv', q * q_dec, s_start)
    return o.reshape(b, h, l, dv), s_final


def gla_chunked(q, k, v, log_f, s0, need_out):
    b, h, l, dk = q.shape
    dv = v.shape[-1]
    n = l // HG_CHUNK
    q, k, log_f = (t.reshape(b, h, n, HG_CHUNK, dk) for t in (q, k, log_f))
    v = v.reshape(b, h, n, HG_CHUNK, dv)
    cum = jnp.cumsum(log_f, axis=3)
    last = cum[:, :, :, -1:, :]
    ds = jnp.einsum('bhnsd,bhnsv->bhndv', k * jnp.exp(last - cum), v)
    s_start, s_final = chunk_states(jnp.swapaxes(jnp.exp(last), 3, 4), ds, s0)
    if not need_out:
        return None, s_final
    pos = jnp.arange(HG_CHUNK)
    causal = (pos[:, None] >= pos[None, :])[:, :, None]

    def intra(blk):
        qc, kc, vc, cc = blk
        diff = cc[:, :, :, None, :] - cc[:, :, None, :, :]
        decay = jnp.where(causal, jnp.exp(jnp.where(causal, diff, 0.0)), 0.0)
        scores = jnp.einsum('bhtd,bhsd,bhtsd->bhts', qc, kc, decay)
        return jnp.einsum('bhts,bhsv->bhtv', scores, vc)

    o_intra = jnp.moveaxis(lax.map(intra, tuple(jnp.moveaxis(t, 2, 0) for t in (q, k, v, cum))), 0, 2)
    o = o_intra + jnp.einsum('bhntd,bhndv->bhntv', q * jnp.exp(cum), s_start)
    return o.reshape(b, h, l, dv), s_final


def gdn_chunked(q, k, v, g, beta, s0, need_out):
    b, h, l, dk = q.shape
    dv = v.shape[-1]
    n = l // GDN_CHUNK
    q = q.reshape(b, h, n, GDN_CHUNK, dk)
    k = k.reshape(b, h, n, GDN_CHUNK, dk)
    v = v.reshape(b, h, n, GDN_CHUNK, dv)
    g = g.reshape(b, h, n, GDN_CHUNK)
    beta = beta.reshape(b, h, n, GDN_CHUNK)
    cg = jnp.cumsum(g, axis=-1)
    diff = cg[..., :, None] - cg[..., None, :]
    pos = jnp.arange(GDN_CHUNK)
    strict = pos[:, None] > pos[None, :]
    causal = pos[:, None] >= pos[None, :]
    kk = jnp.einsum('bhntd,bhnsd->bhnts', k, k)
    a_mat = jnp.where(strict, beta[..., None] * kk * jnp.exp(jnp.where(strict, diff, 0.0)), 0.0)
    rhs = jnp.concatenate([v * beta[..., None], k * (beta * jnp.exp(cg))[..., None]], axis=-1)
    sol = lax.linalg.triangular_solve(a_mat, rhs, left_side=True, lower=True, unit_diagonal=True)
    u, w = sol[..., :dv], sol[..., dv:]
    g_last = cg[..., -1:]
    k_tail = k * jnp.exp(g_last - cg)[..., None]
    chunk_decay = jnp.exp(g_last)[..., None]

    def step(s, inp):
        u_c, w_c, k_c, a_c = inp
        delta = u_c - w_c @ s
        return a_c * s + jnp.einsum('bhsd,bhsv->bhdv', k_c, delta), s

    s_final, s_start = lax.scan(step, s0, tuple(jnp.moveaxis(t, 2, 0) for t in (u, w, k_tail, chunk_decay)))
    if not need_out:
        return None, s_final
    s_start = jnp.moveaxis(s_start, 0, 2)
    delta = u - jnp.einsum('bhntd,bhndv->bhntv', w, s_start)
    pmat = jnp.where(causal, jnp.einsum('bhntd,bhnsd->bhnts', q, k) * jnp.exp(jnp.where(causal, diff, 0.0)), 0.0)
    o = (jnp.einsum('bhntd,bhndv->bhntv', q * jnp.exp(cg)[..., None], s_start)
         + jnp.einsum('bhnts,bhnsv->bhntv', pmat, delta))
    return o.reshape(b, h, l, dv), s_final


def bidirectional(fn_f, fn_b, ctx_f, lat_f, ctx_b, lat_b, s0, need_ctx):
    flip = lambda a: jnp.flip(a, axis=2)
    oc_f, sc_f = fn_f(*ctx_f, s0, need_ctx)
    ol_f, _ = fn_f(*lat_f, sc_f, True)
    oc_b, sc_b = fn_b(*[flip(a) for a in ctx_b], s0, need_ctx)
    ol_b, _ = fn_b(*[flip(a) for a in lat_b], sc_b, True)
    o_lat = ol_f + flip(ol_b)
    o_ctx = oc_f + flip(oc_b) if need_ctx else None
    return o_ctx, o_lat


def retention_mixer(pc, pl, cos, sin, norm_g, need_ctx):
    def prep(p, rope):
        b, l, _ = p['ret_q'].shape
        q = p['ret_q'].reshape(b, l, RET_HEADS, HEAD_DIM)
        k = p['ret_k'].reshape(b, l, RET_HEADS, HEAD_DIM) * (HEAD_DIM ** -0.5)
        if rope:
            q, k = apply_rope(q, cos, sin), apply_rope(k, cos, sin)
        return (q.transpose(0, 2, 1, 3).astype(F32), k.transpose(0, 2, 1, 3).astype(F32),
                to_heads(p['ret_v'], RET_HEADS))

    log_gamma = jnp.log1p(-jnp.exp2(-5.0 - jnp.arange(RET_HEADS, dtype=F32)))
    fn_f = functools.partial(retention_chunked, log_gamma=log_gamma)
    fn_b = functools.partial(retention_chunked, log_gamma=log_gamma[::-1])
    ctx_args, lat_args = prep(pc, False), prep(pl, True)
    s0 = jnp.zeros((pl['ret_q'].shape[0], RET_HEADS, HEAD_DIM, HEAD_DIM), F32)
    o_c, o_l = bidirectional(fn_f, fn_b, ctx_args, lat_args, ctx_args, lat_args, s0, need_ctx)
    y_lat = head_norm_gate(o_l, norm_g, pl['ret_g'])
    y_ctx = head_norm_gate(o_c, norm_g, pc['ret_g']) if need_ctx else None
    return y_ctx, y_lat


def hgrn2_mixer(pc, pl, lb_f, lb_b, norm_g, need_ctx):
    def forget(z, lb):
        z = z.astype(F32)
        f = lb + (1.0 - lb) * jax.nn.sigmoid(z)
        log_f = jnp.log(f)
        k = (1.0 - lb) * jax.nn.sigmoid(-z)
        return to_heads(k, HG_HEADS), to_heads(log_f, HG_HEADS)

    def prep(p):
        q = to_heads(jax.nn.silu(p['hg_q']), HG_HEADS)
        i = to_heads(p['hg_i'], HG_HEADS)
        k_f, lf_f = forget(p['hg_f_fwd'], lb_f)
        k_b, lf_b = forget(p['hg_f_bwd'], lb_b)
        return (q, k_f, i, lf_f), (q, k_b, i, lf_b)

    ctx_f, ctx_b = prep(pc)
    lat_f, lat_b = prep(pl)
    s0 = jnp.zeros((pl['hg_q'].shape[0], HG_HEADS, HEAD_DIM, HEAD_DIM), F32)
    o_c, o_l = bidirectional(gla_chunked, gla_chunked, ctx_f, lat_f, ctx_b, lat_b, s0, need_ctx)
    y_lat = head_norm_gate(o_l, norm_g, pl['hg_g'])
    y_ctx = head_norm_gate(o_c, norm_g, pc['hg_g']) if need_ctx else None
    return y_ctx, y_lat


def sdpa_block(qb, k, v):
    s = jnp.einsum('bhgtd,bhsd->bhgts', qb, k).astype(F32) * (HEAD_DIM ** -0.5)
    p = jax.nn.softmax(s, axis=-1).astype(v.dtype)
    return jnp.einsum('bhgts,bhsd->bhgtd', p, v)


def gqa_mixer(pc, pl, cos, sin, q_g, k_g, need_ctx):
    groups = ATT_Q_HEADS // ATT_KV_HEADS

    def prep_q(p, rope):
        b, l, _ = p['at_q'].shape
        q = rmsnorm(p['at_q'].reshape(b, l, ATT_Q_HEADS, HEAD_DIM), q_g)
        if rope:
            q = apply_rope(q, cos, sin)
        return q.reshape(b, l, ATT_KV_HEADS, groups, HEAD_DIM)

    def prep_kv(p, rope):
        b, l, _ = p['at_k'].shape
        k = rmsnorm(p['at_k'].reshape(b, l, ATT_KV_HEADS, HEAD_DIM), k_g)
        if rope:
            k = apply_rope(k, cos, sin)
        return k, p['at_v'].reshape(b, l, ATT_KV_HEADS, HEAD_DIM)

    kc, vc = prep_kv(pc, False)
    kl, vl = prep_kv(pl, True)
    ql = prep_q(pl, True)
    b, l = ql.shape[:2]
    k_all = jnp.concatenate([kc, kl], axis=1).transpose(0, 2, 1, 3)
    v_all = jnp.concatenate([vc, vl], axis=1).transpose(0, 2, 1, 3)
    n_blocks = l // ATT_BLOCK
    q_blocks = ql.reshape(b, n_blocks, ATT_BLOCK, ATT_KV_HEADS, groups, HEAD_DIM).transpose(1, 0, 3, 4, 2, 5)
    o = lax.map(lambda qb: sdpa_block(qb, k_all, v_all), q_blocks)
    y_lat = o.transpose(1, 0, 4, 2, 3, 5).reshape(b, l, ATT_Q_HEADS * HEAD_DIM)
    y_ctx = None
    if need_ctx:
        qc = prep_q(pc, False)
        lc = qc.shape[1]
        o_c = sdpa_block(qc.transpose(0, 2, 3, 1, 4), kc.transpose(0, 2, 1, 3), vc.transpose(0, 2, 1, 3))
        y_ctx = o_c.transpose(0, 3, 1, 2, 4).reshape(b, lc, ATT_Q_HEADS * HEAD_DIM)
    return y_ctx, y_lat


def gdn_mixer(pc, pl, conv_w, a_log, dt_bias, norm_g, need_ctx):
    def prep(p):
        qkv = jnp.concatenate([p['gd_q'], p['gd_k'], p['gd_v']], axis=-1)
        qkv = jax.nn.silu(dwconv_centred(qkv, conv_w))
        q, k, v = jnp.split(qkv, 3, axis=-1)
        q = l2norm(to_heads(q, GDN_HEADS)) * (HEAD_DIM ** -0.5)
        k = l2norm(to_heads(k, GDN_HEADS))
        v = to_heads(v, GDN_HEADS)

        def gates(a, bb, d):
            g = -jnp.exp(a_log[d].astype(F32)) * jax.nn.softplus(a.astype(F32) + dt_bias[d].astype(F32))
            beta = jax.nn.sigmoid(bb.astype(F32))
            return jnp.swapaxes(g, 1, 2), jnp.swapaxes(beta, 1, 2)

        g_f, beta_f = gates(p['gd_a_fwd'], p['gd_b_fwd'], 0)
        g_b, beta_b = gates(p['gd_a_bwd'], p['gd_b_bwd'], 1)
        return (q, k, v, g_f, beta_f), (q, k, v, g_b, beta_b)

    ctx_f, ctx_b = prep(pc)
    lat_f, lat_b = prep(pl)
    s0 = jnp.zeros((pl['gd_q'].shape[0], GDN_HEADS, HEAD_DIM, HEAD_DIM), F32)
    o_c, o_l = bidirectional(gdn_chunked, gdn_chunked, ctx_f, lat_f, ctx_b, lat_b, s0, need_ctx)
    y_lat = head_norm_gate(o_l, norm_g, pl['gd_g'])
    y_ctx = head_norm_gate(o_c, norm_g, pc['gd_g']) if need_ctx else None
    return y_ctx, y_lat


def merge_branches(h, ys, w_branch, w_merge, w_out):
    m = jax.nn.sigmoid(h @ w_merge[0]) * (ys[0] @ w_branch[0])
    for n in range(1, N_BRANCHES):
        m = m + jax.nn.sigmoid(h @ w_merge[n]) * (ys[n] @ w_branch[n])
    return m @ w_out


def token_mixer(h_ctx, h_lat, p, lb_f, lb_b, cos, sin, need_ctx):
    pc = split_cols(h_ctx @ p['w_in'])
    pl = split_cols(h_lat @ p['w_in'])
    ya_c, ya_l = retention_mixer(pc, pl, cos, sin, p['ret_norm_g'], need_ctx)
    yb_c, yb_l = hgrn2_mixer(pc, pl, lb_f, lb_b, p['hg_norm_g'], need_ctx)
    yc_c, yc_l = gqa_mixer(pc, pl, cos, sin, p['at_q_norm_g'], p['at_k_norm_g'], need_ctx)
    yd_c, yd_l = gdn_mixer(pc, pl, p['gd_conv_w'], p['gd_a_log'], p['gd_dt_bias'], p['gd_norm_g'], need_ctx)
    y_lat = merge_branches(h_lat, (ya_l, yb_l, yc_l, yd_l), p['w_branch'], p['w_merge'], p['w_out'])
    y_ctx = None
    if need_ctx:
        y_ctx = merge_branches(h_ctx, (ya_c, yb_c, yc_c, yd_c), p['w_branch'], p['w_merge'], p['w_out'])
    return y_ctx, y_lat


def ec_moe(h, w_router, w_g, w_u, w_d):
    b, n, _ = h.shape
    cap = CAPACITY_FACTOR * n // N_EXPERTS
    aff = jax.nn.softmax((h @ w_router).astype(F32), axis=-1)
    vals, idx = lax.top_k(jnp.swapaxes(aff, 1, 2), cap)
    bidx = jnp.arange(b)[:, None, None]
    xe = h[bidx, idx]
    act = jax.nn.silu(jnp.einsum('becd,edf->becf', xe, w_g)) * jnp.einsum('becd,edf->becf', xe, w_u)
    ye = jnp.einsum('becf,efd->becd', act, w_d) * vals[..., None].astype(h.dtype)
    return jnp.zeros_like(h).at[bidx, idx].add(ye)


def hybrid_layer(x_ctx, x_lat, mod_ctx, mod_lat, p, lb_f, lb_b, cos, sin, need_ctx):
    sh_c, sc_c, gt_c, shf_c, scf_c, gtf_c = jnp.split(mod_ctx, 6, axis=-1)
    sh_l, sc_l, gt_l, shf_l, scf_l, gtf_l = jnp.split(mod_lat, 6, axis=-1)
    h_ctx = modulate(rmsnorm(x_ctx, p['g_pre_mix']), sh_c, sc_c)
    h_lat = modulate(rmsnorm(x_lat, p['g_pre_mix']), sh_l, sc_l)
    y_ctx, y_lat = token_mixer(h_ctx, h_lat, p, lb_f, lb_b, cos, sin, need_ctx)
    x_lat = x_lat + gt_l * rmsnorm(y_lat, p['g_post_mix'])
    f_lat = ec_moe(modulate(rmsnorm(x_lat, p['g_pre_ffn']), shf_l, scf_l),
                   p['w_router'], p['w_exp_gate'], p['w_exp_up'], p['w_exp_down'])
    x_lat = x_lat + gtf_l * rmsnorm(f_lat, p['g_post_ffn'])
    if not need_ctx:
        return None, x_lat
    x_ctx = x_ctx + gt_c * rmsnorm(y_ctx, p['g_post_mix'])
    f_ctx = ec_moe(modulate(rmsnorm(x_ctx, p['g_pre_ffn']), shf_c, scf_c),
                   p['w_router'], p['w_exp_gate'], p['w_exp_up'], p['w_exp_down'])
    x_ctx = x_ctx + gtf_c * rmsnorm(f_ctx, p['g_post_ffn'])
    return x_ctx, x_lat


def hgrn_lower_bounds(logits):
    pr = jax.nn.softmax(logits.astype(F32), axis=1)
    return jnp.cumsum(pr, axis=1) - pr[:, :1]


def setup_inputs(seed: int = 0) -> dict:
    key = jax.random.key(seed)
    ks = jax.random.split(key, 32)
    D, F, E = D_MODEL, EXPERT_FF, N_EXPERTS

    def nrm(k, shape, scale):
        return jax.random.normal(k, shape, F32) * scale

    def gain(k, shape):
        return 1.0 + 0.05 * jax.random.normal(k, shape, F32)

    dt = jnp.exp(jax.random.uniform(ks[18], (DEPTH, 2, GDN_HEADS), F32, math.log(1e-3), math.log(1e-1)))
    return {
        'x': nrm(ks[0], (BATCH, SEQ, D), 1.0),
        'c': nrm(ks[1], (BATCH, D), 1.0),
        'ctx': nrm(ks[2], (BATCH, CTX_LEN, D), 1.0),
        'c_ctx': nrm(ks[3], (D,), 1.0),
        'w_ada': nrm(ks[4], (DEPTH, D, 6 * D), 0.5 * D ** -0.5),
        'b_ada': nrm(ks[5], (DEPTH, 6 * D), 0.02),
        'g_pre_mix': gain(ks[6], (DEPTH, D)),
        'g_post_mix': gain(ks[7], (DEPTH, D)),
        'g_pre_ffn': gain(ks[8], (DEPTH, D)),
        'g_post_ffn': gain(ks[9], (DEPTH, D)),
        'w_in': nrm(ks[10], (DEPTH, D, D_IN), D ** -0.5),
        'ret_norm_g': gain(ks[11], (DEPTH, HEAD_DIM)),
        'hg_lb_logits': nrm(ks[12], (2, DEPTH, HG_HEADS * HEAD_DIM), 1.0),
        'hg_norm_g': gain(ks[13], (DEPTH, HEAD_DIM)),
        'at_q_norm_g': gain(ks[14], (DEPTH, HEAD_DIM)),
        'at_k_norm_g': gain(ks[15], (DEPTH, HEAD_DIM)),
        'gd_conv_w': nrm(ks[16], (DEPTH, CONV_W, 3 * GDN_HEADS * HEAD_DIM), CONV_W ** -0.5),
        'gd_a_log': jnp.log(jax.random.uniform(ks[17], (DEPTH, 2, GDN_HEADS), F32, 1.0, 16.0)),
        'gd_dt_bias': dt + jnp.log(-jnp.expm1(-dt)),
        'gd_norm_g': gain(ks[19], (DEPTH, HEAD_DIM)),
        'w_branch': nrm(ks[20], (DEPTH, N_BRANCHES, BRANCH_W, D), BRANCH_W ** -0.5),
        'w_merge': nrm(ks[21], (DEPTH, N_BRANCHES, D, D), D ** -0.5),
        'w_out': nrm(ks[22], (DEPTH, D, D), D ** -0.5),
        'w_router': nrm(ks[23], (DEPTH, D, E), D ** -0.5),
        'w_exp_gate': nrm(ks[24], (DEPTH, E, D, F), D ** -0.5),
        'w_exp_up': nrm(ks[25], (DEPTH, E, D, F), D ** -0.5),
        'w_exp_down': nrm(ks[26], (DEPTH, E, F, D), F ** -0.5),
    }


def reference(x, c, ctx, c_ctx, w_ada, b_ada, g_pre_mix, g_post_mix, g_pre_ffn, g_post_ffn, w_in,
              ret_norm_g, hg_lb_logits, hg_norm_g, at_q_norm_g, at_k_norm_g, gd_conv_w, gd_a_log,
              gd_dt_bias, gd_norm_g, w_branch, w_merge, w_out, w_router, w_exp_gate, w_exp_up, w_exp_down):
    cos, sin = axial_rope_tables(x.shape[1])
    lower = hgrn_lower_bounds(hg_lb_logits)
    x_ctx, x_lat = ctx, x
    for l in range(DEPTH):
        p = {
            'w_in': w_in[l], 'ret_norm_g': ret_norm_g[l], 'hg_norm_g': hg_norm_g[l],
            'at_q_norm_g': at_q_norm_g[l], 'at_k_norm_g': at_k_norm_g[l], 'gd_conv_w': gd_conv_w[l],
            'gd_a_log': gd_a_log[l], 'gd_dt_bias': gd_dt_bias[l], 'gd_norm_g': gd_norm_g[l],
            'w_branch': w_branch[l], 'w_merge': w_merge[l], 'w_out': w_out[l], 'w_router': w_router[l],
            'w_exp_gate': w_exp_gate[l], 'w_exp_up': w_exp_up[l], 'w_exp_down': w_exp_down[l],
            'g_pre_mix': g_pre_mix[l], 'g_post_mix': g_post_mix[l],
            'g_pre_ffn': g_pre_ffn[l], 'g_post_ffn': g_post_ffn[l],
        }
        mod_lat = (jax.nn.silu(c) @ w_ada[l] + b_ada[l])[:, None, :]
        mod_ctx = (jax.nn.silu(c_ctx) @ w_ada[l] + b_ada[l])[None, None, :]
        x_ctx, x_lat = hybrid_layer(x_ctx, x_lat, mod_ctx, mod_lat, p, lower[0, l], lower[1, l],
                                    cos, sin, l < DEPTH - 1)
    return x_lat
```

```cpp
#include <hip/hip_runtime.h>
#include <cstdio>
#include <cstdint>

#define DEV __device__ __forceinline__
typedef unsigned short bf16_t;
typedef float f32x4 __attribute__((ext_vector_type(4)));

constexpr int NC = 256, NL = 16384, T = NC + NL, D = 1024, DIN = 3856, ZW = 3840, GW = 64;
constexpr int NE = 16, CAP_L = 2048, CAP_C = 32, EROWS = 2304;
constexpr float EPS = 1e-6f;
constexpr float C2 = 0.125f * 1.4426950408889634f;
constexpr int ZC_RQ = 0, ZC_RK = 256, ZC_RV = 512, ZC_RG = 768, ZC_HQ = 1024, ZC_HFF = 1280, ZC_HFB = 1536, ZC_HI = 1792, ZC_HG = 2048,
              ZC_AQ = 2304, ZC_AK = 2560, ZC_AV = 2688, ZC_GQ = 2816, ZC_GK = 3072, ZC_GV = 3328, ZC_GG = 3584;
enum { I_X = 0, I_C, I_CTX, I_CCTX, I_WADA, I_BADA, I_GPM, I_GPOM, I_GPF, I_GPOF, I_WIN, I_RNG, I_LBL, I_HNG, I_AQG, I_AKG, I_CONV, I_ALOG, I_DTB, I_GNG,
       I_WBR, I_WMG, I_WOUT, I_WRT, I_WEG, I_WEU, I_WED, N_IN };

constexpr size_t MiB = 1u << 20;
constexpr size_t WS_MOD = 1 * MiB;
constexpr size_t WS_LB = WS_MOD + 128 * 1024;
constexpr size_t WS_ROPE = WS_LB + 8 * 1024;
constexpr size_t WS_GATE = 2 * MiB;
constexpr size_t WS_AFF = 4 * MiB;
constexpr size_t WS_INV = 6 * MiB;
constexpr size_t WS_IDX = 8 * MiB;
constexpr size_t WS_VAL = WS_IDX + 256 * 1024;
constexpr size_t WS_XC = 16 * MiB;
constexpr size_t WS_H = 81 * MiB;
constexpr size_t WS_Y = 114 * MiB;
constexpr size_t WS_M = 147 * MiB;
constexpr size_t WS_YO = 180 * MiB;
constexpr size_t WS_Z = 245 * MiB;
constexpr size_t WS_XE = 245 * MiB;
constexpr size_t WS_YE = 317 * MiB;
constexpr size_t WS_ACT = 114 * MiB;
constexpr size_t WS_OACC = 389 * MiB;
constexpr size_t WS_GQKV = 438 * MiB;
constexpr size_t WS_AQ = 463 * MiB;
constexpr size_t WS_AK = 472 * MiB;
constexpr size_t WS_AV = 477 * MiB;
constexpr size_t WS_END = 482 * MiB;

struct P {
    const float* in[N_IN];
    float* out;
    unsigned char* ws;
    int layer, pad;
};

DEV float bf2f(bf16_t v) { return __uint_as_float(((unsigned)v) << 16); }
DEV bf16_t f2bf(float f) { unsigned u = __float_as_uint(f); u += 0x7fffu + ((u >> 16) & 1u); return (bf16_t)(u >> 16); }
DEV float sigm(float x) { return 1.f / (1.f + expf(-x)); }
DEV float silu(float x) { return x / (1.f + expf(-x)); }
DEV float wave_sum(float v) {
#pragma unroll
    for (int o = 1; o < 64; o <<= 1) v += __shfl_xor(v, o);
    return v;
}
template <class Tp> DEV Tp* wsp(const P& p, size_t off) { return (Tp*)(p.ws + off); }

__device__ void ph_prologue(const P& p, int bid, int nb) {
    const int gt = bid * blockDim.x + threadIdx.x, ng = nb * blockDim.x;
    float* MOD = wsp<float>(p, WS_MOD);
    for (int idx = gt; idx < 2 * 2 * 6144; idx += ng) {
        const int l = idx / 12288, w = (idx / 6144) & 1, j = idx % 6144;
        const float* cv = w ? p.in[I_C] : p.in[I_CCTX];
        const float* wa = p.in[I_WADA] + (size_t)l * 1024 * 6144 + j;
        float s = 0.f;
        for (int k = 0; k < 1024; ++k) s += silu(cv[k]) * wa[(size_t)k * 6144];
        MOD[idx] = s + p.in[I_BADA][l * 6144 + j];
    }
    float* LB = wsp<float>(p, WS_LB);
    for (int idx = gt; idx < 2 * 2 * 256; idx += ng) {
        const int dir = idx / 512, l = (idx / 256) & 1, i = idx % 256;
        const float l0 = p.in[I_LBL][(dir * 2 + 0) * 256 + i], l1 = p.in[I_LBL][(dir * 2 + 1) * 256 + i];
        LB[idx] = l ? 1.f / (1.f + expf(l0 - l1)) : 0.f;
    }
    float* RC = wsp<float>(p, WS_ROPE);
    for (int idx = gt; idx < 256 * 16; idx += ng) {
        const int pos = idx / 16, j = idx % 16;
        const double inv = pow(10000.0, -(double)j / 16.0), a = (double)pos * inv;
        RC[idx] = (float)cos(a); RC[4096 + idx] = (float)sin(a);
    }
    f32x4* XC = wsp<f32x4>(p, WS_XC);
    const f32x4* xs = (const f32x4*)p.in[I_X]; const f32x4* cs = (const f32x4*)p.in[I_CTX];
    for (int idx = gt; idx < T * 256; idx += ng) XC[idx] = idx < NC * 256 ? cs[idx] : xs[idx - NC * 256];
}

__device__ void ph_rows0(const P& p, int bid, int nb) {
    const int l = p.layer, lane = threadIdx.x & 63, wpb = blockDim.x >> 6;
    const int gw = bid * wpb + (threadIdx.x >> 6), ngw = nb * wpb;
    const float* XC = wsp<float>(p, WS_XC); bf16_t* H = wsp<bf16_t>(p, WS_H); float* GATE = wsp<float>(p, WS_GATE);
    const float* g = p.in[I_GPM] + l * 1024;
    const float* win = p.in[I_WIN] + (size_t)l * 1024 * DIN + 3584;
    for (int r = gw; r < T; r += ngw) {
        const float* mod = wsp<float>(p, WS_MOD) + (l * 2 + (r >= NC ? 1 : 0)) * 6144;
        f32x4 v[4]; float ss = 0.f;
#pragma unroll
        for (int j = 0; j < 4; ++j) { v[j] = *(const f32x4*)(XC + (size_t)r * 1024 + j * 256 + lane * 4); ss += v[j].x * v[j].x + v[j].y * v[j].y + v[j].z * v[j].z + v[j].w * v[j].w; }
        const float rstd = rsqrtf(wave_sum(ss) * (1.f / 1024.f) + EPS);
        float ga[16];
#pragma unroll
        for (int i = 0; i < 16; ++i) ga[i] = 0.f;
#pragma unroll
        for (int j = 0; j < 4; ++j) {
            const int k0 = j * 256 + lane * 4; float h[4];
#pragma unroll
            for (int e = 0; e < 4; ++e) { const int k = k0 + e; h[e] = v[j][e] * rstd * g[k] * (1.f + mod[1024 + k]) + mod[k]; }
            *(uint2*)(H + (size_t)r * 1024 + k0) = make_uint2((unsigned)f2bf(h[0]) | ((unsigned)f2bf(h[1]) << 16), (unsigned)f2bf(h[2]) | ((unsigned)f2bf(h[3]) << 16));
#pragma unroll
            for (int e = 0; e < 4; ++e) {
                const float* wr = win + (size_t)(k0 + e) * DIN;
#pragma unroll
                for (int q = 0; q < 4; ++q) { const f32x4 w4 = *(const f32x4*)(wr + q * 4); ga[q * 4 + 0] += h[e] * w4.x; ga[q * 4 + 1] += h[e] * w4.y; ga[q * 4 + 2] += h[e] * w4.z; ga[q * 4 + 3] += h[e] * w4.w; }
            }
        }
#pragma unroll
        for (int i = 0; i < 16; ++i) { const float s = wave_sum(ga[i]); if (lane == i) GATE[(size_t)r * 16 + i] = s; }
    }
}

template <class AF, class BF> DEV void tile_mac(float (&acc)[32], int r0, int col, int K, const AF& a, const BF& b, float* lds) {
    const int tx = threadIdx.x;
    for (int k0 = 0; k0 < K; k0 += 64) {
        __syncthreads();
#pragma unroll
        for (int i = 0; i < 8; ++i) { const int e = tx + i * 256, rr = e >> 6, kk = e & 63; lds[rr * 64 + kk] = a(r0 + rr, k0 + kk); }
        __syncthreads();
#pragma unroll 4
        for (int kk = 0; kk < 64; kk += 4) {
            const float w0 = b(k0 + kk, col), w1 = b(k0 + kk + 1, col), w2 = b(k0 + kk + 2, col), w3 = b(k0 + kk + 3, col);
#pragma unroll
            for (int rr = 0; rr < 32; ++rr) { const f32x4 av = *(const f32x4*)(lds + rr * 64 + kk); acc[rr] += av.x * w0 + av.y * w1 + av.z * w2 + av.w * w3; }
        }
    }
}
#define ZERO32(a) _Pragma("unroll") for (int _i = 0; _i < 32; ++_i) a[_i] = 0.f

__device__ void ph_g1(const P& p, int bid, int nb, float* lds) {
    const int l = p.layer; const bf16_t* H = wsp<bf16_t>(p, WS_H); bf16_t* Z = wsp<bf16_t>(p, WS_Z);
    const float* W = p.in[I_WIN] + (size_t)l * 1024 * DIN;
    const int ntn = ZW / 256, ntiles = (T / 32) * ntn;
    for (int t = bid; t < ntiles; t += nb) {
        const int r0 = (t / ntn) * 32, n = (t % ntn) * 256 + threadIdx.x, oc = n < 3584 ? n : n + 16;
        float acc[32]; ZERO32(acc);
        tile_mac(acc, r0, oc, 1024, [&](int r, int k) { return bf2f(H[(size_t)r * 1024 + k]); }, [&](int k, int c) { return W[(size_t)k * DIN + c]; }, lds);
#pragma unroll
        for (int rr = 0; rr < 32; ++rr) Z[(size_t)(r0 + rr) * ZW + n] = f2bf(acc[rr]);
    }
}

__device__ void ph_mixprep(const P& p, int bid, int nb) {
    const int l = p.layer; const int gt = bid * blockDim.x + threadIdx.x, ng = nb * blockDim.x;
    const bf16_t* Z = wsp<bf16_t>(p, WS_Z); const float* RC = wsp<float>(p, WS_ROPE);
    bf16_t* AQ = wsp<bf16_t>(p, WS_AQ); bf16_t* AK = wsp<bf16_t>(p, WS_AK); bf16_t* AV = wsp<bf16_t>(p, WS_AV); bf16_t* GQKV = wsp<bf16_t>(p, WS_GQKV);
    for (int idx = gt; idx < T * 20; idx += ng) {
        const int r = idx / 20, task = idx % 20;
        float v[64];
        if (task < 8) {
            const int zc = task < 4 ? ZC_AQ + task * 64 : (task < 6 ? ZC_AK + (task - 4) * 64 : ZC_AV + (task - 6) * 64);
#pragma unroll
            for (int d = 0; d < 64; ++d) v[d] = bf2f(Z[(size_t)r * ZW + zc + d]);
            if (task < 6) {
                const float* g = (task < 4 ? p.in[I_AQG] : p.in[I_AKG]) + l * 64;
                float ss = 0.f;
#pragma unroll
                for (int d = 0; d < 64; ++d) ss += v[d] * v[d];
                const float rs = rsqrtf(ss * (1.f / 64.f) + EPS);
#pragma unroll
                for (int d = 0; d < 64; ++d) v[d] = v[d] * rs * g[d];
                if (r >= NC) {
                    const int tl = r - NC, prow = tl / GW, pcol = tl % GW;
#pragma unroll
                    for (int a = 0; a < 2; ++a) {
                        const int pos = a ? pcol : prow;
#pragma unroll
                        for (int j = 0; j < 16; ++j) { const float c = RC[pos * 16 + j], s = RC[4096 + pos * 16 + j], x1 = v[a * 32 + j], x2 = v[a * 32 + 16 + j]; v[a * 32 + j] = x1 * c - x2 * s; v[a * 32 + 16 + j] = x2 * c + x1 * s; }
                    }
                }
                if (task < 4) {
#pragma unroll
                    for (int d = 0; d < 64; ++d) v[d] *= C2;
                }
            }
            bf16_t* dst = task < 4 ? AQ + (size_t)r * 256 + task * 64 : (task < 6 ? AK + (size_t)r * 128 + (task - 4) * 64 : AV + (size_t)r * 128 + (task - 6) * 64);
#pragma unroll
            for (int d = 0; d < 64; ++d) dst[d] = f2bf(v[d]);
        } else {
            const int which = (task - 8) / 4, h = (task - 8) % 4, ch = which * 256 + h * 64;
            const float* cw = p.in[I_CONV] + (size_t)l * 3 * 768 + ch;
            const bool first = (r == 0 || r == NC), last = (r == NC - 1 || r == T - 1);
            float ss = 0.f;
#pragma unroll
            for (int d = 0; d < 64; ++d) {
                const size_t zo = (size_t)r * ZW + ZC_GQ + ch + d;
                float s = bf2f(Z[zo]) * cw[768 + d];
                if (!first) s += bf2f(Z[zo - ZW]) * cw[d];
                if (!last) s += bf2f(Z[zo + ZW]) * cw[2 * 768 + d];
                v[d] = silu(s); ss += v[d] * v[d];
            }
            if (which < 2) { const float rs = rsqrtf(ss + EPS) * (which == 0 ? 0.125f : 1.f);
#pragma unroll
                for (int d = 0; d < 64; ++d) v[d] *= rs; }
            bf16_t* dst = GQKV + ((size_t)which * T + r) * 256 + h * 64;
#pragma unroll
            for (int d = 0; d < 64; ++d) dst[d] = f2bf(v[d]);
        }
    }
    f32x4* OA = wsp<f32x4>(p, WS_OACC);
    for (int idx = gt; idx < 3 * T * 64; idx += ng) OA[idx] = (f32x4){0.f, 0.f, 0.f, 0.f};
}

__device__ void ph_recur_naive(const P& p, int unit) {
    const int l = p.layer, mixer = unit / 8, dir = (unit / 4) & 1, h = unit & 3, lane = threadIdx.x & 63;
    const bf16_t* Z = wsp<bf16_t>(p, WS_Z); const float* RC = wsp<float>(p, WS_ROPE); const float* GATE = wsp<float>(p, WS_GATE);
    const bf16_t* GQKV = wsp<bf16_t>(p, WS_GQKV);
    float* OA = wsp<float>(p, WS_OACC) + (size_t)mixer * T * 256;
    float S[64];
#pragma unroll
    for (int d = 0; d < 64; ++d) S[d] = 0.f;
    const int hg_ = dir ? 3 - h : h;
    const float gamma = 1.f - exp2f(-5.f - (float)hg_);
    const float lb = mixer == 1 ? wsp<float>(p, WS_LB)[(dir * 2 + l) * 256 + h * 64 + lane] : 0.f;
    const float Aexp = mixer == 2 ? expf(p.in[I_ALOG][(l * 2 + dir) * 4 + h]) : 0.f, dtb = mixer == 2 ? p.in[I_DTB][(l * 2 + dir) * 4 + h] : 0.f;
    auto rowof = [&](int step) { if (step < NC) return dir ? NC - 1 - step : step; const int s = step - NC; return NC + (dir ? NL - 1 - s : s); };
    float n0, n1, n2, n3 = 0.f, n4 = 0.f;
    auto loadraw = [&](int r) {
        if (mixer == 0) { n0 = bf2f(Z[(size_t)r * ZW + ZC_RQ + h * 64 + lane]); n1 = bf2f(Z[(size_t)r * ZW + ZC_RK + h * 64 + lane]); n2 = bf2f(Z[(size_t)r * ZW + ZC_RV + h * 64 + lane]); }
        else if (mixer == 1) { n0 = bf2f(Z[(size_t)r * ZW + ZC_HQ + h * 64 + lane]); n1 = bf2f(Z[(size_t)r * ZW + (dir ? ZC_HFB : ZC_HFF) + h * 64 + lane]); n2 = bf2f(Z[(size_t)r * ZW + ZC_HI + h * 64 + lane]); }
        else { n0 = bf2f(GQKV[((size_t)0 * T + r) * 256 + h * 64 + lane]); n1 = bf2f(GQKV[((size_t)1 * T + r) * 256 + h * 64 + lane]); n2 = bf2f(GQKV[((size_t)2 * T + r) * 256 + h * 64 + lane]);
               n3 = GATE[(size_t)r * 16 + dir * 4 + h]; n4 = GATE[(size_t)r * 16 + 8 + dir * 4 + h]; }
    };
    int rnext = rowof(0); loadraw(rnext);
    for (int step = 0; step < T; ++step) {
        const int r = rnext; const float c0 = n0, c1 = n1, c2 = n2, c3 = n3, c4 = n4;
        if (step + 1 < T) { rnext = rowof(step + 1); loadraw(rnext); }
        float qv, kv, vv, fv = 0.f, a_t = 0.f, be = 0.f;
        if (mixer == 0) {
            qv = c0; kv = c1 * 0.125f; vv = c2;
            if (r >= NC) {
                const int tl = r - NC, pos = (lane >= 32) ? tl % GW : tl / GW, j = lane & 15; const bool hi = (lane & 16) != 0;
                const float c = RC[pos * 16 + j], s = RC[4096 + pos * 16 + j];
                const float qp = __shfl_xor(qv, 16), kp = __shfl_xor(kv, 16);
                qv = hi ? qv * c + qp * s : qv * c - qp * s;
                kv = hi ? kv * c + kp * s : kv * c - kp * s;
            }
        } else if (mixer == 1) {
            qv = silu(c0); fv = lb + (1.f - lb) * sigm(c1); kv = (1.f - lb) * sigm(-c1); vv = c2;
        } else {
            qv = c0; kv = c1; vv = c2;
            const float av = c3 + dtb; const float sp = av > 20.f ? av : log1pf(expf(av));
            a_t = expf(-Aexp * sp); be = sigm(c4);
        }
        float o = 0.f;
        if (mixer == 0) {
#pragma unroll
            for (int d = 0; d < 64; ++d) { const float kd = __shfl(kv, d), qd = __shfl(qv, d); S[d] = gamma * S[d] + kd * vv; o += qd * S[d]; }
        } else if (mixer == 1) {
#pragma unroll
            for (int d = 0; d < 64; ++d) { const float kd = __shfl(kv, d), qd = __shfl(qv, d), fd = __shfl(fv, d); S[d] = fd * S[d] + kd * vv; o += qd * S[d]; }
        } else {
            float kS = 0.f;
#pragma unroll
            for (int d = 0; d < 64; ++d) kS += __shfl(kv, d) * S[d];
            const float w = be * (vv - a_t * kS);
#pragma unroll
            for (int d = 0; d < 64; ++d) { const float kd = __shfl(kv, d), qd = __shfl(qv, d); S[d] = a_t * S[d] + kd * w; o += qd * S[d]; }
        }
        atomicAdd(OA + (size_t)r * 256 + h * 64 + lane, o);
    }
}

__device__ void ph_headnorm(const P& p, int bid, int nb) {
    const int l = p.layer; const int gt = bid * blockDim.x + threadIdx.x, ng = nb * blockDim.x;
    const bf16_t* Z = wsp<bf16_t>(p, WS_Z); bf16_t* Y = wsp<bf16_t>(p, WS_Y);
    for (int idx = gt; idx < T * 12; idx += ng) {
        const int r = idx / 12, mixer = (idx % 12) / 4, h = idx % 4;
        const float* o = wsp<float>(p, WS_OACC) + ((size_t)mixer * T + r) * 256 + h * 64;
        const float* g = (mixer == 0 ? p.in[I_RNG] : mixer == 1 ? p.in[I_HNG] : p.in[I_GNG]) + l * 64;
        const int zg = (mixer == 0 ? ZC_RG : mixer == 1 ? ZC_HG : ZC_GG) + h * 64, br = mixer == 2 ? 3 : mixer;
        float v[64], ss = 0.f;
#pragma unroll
        for (int d = 0; d < 64; ++d) { v[d] = o[d]; ss += v[d] * v[d]; }
        const float rs = rsqrtf(ss * (1.f / 64.f) + EPS);
#pragma unroll
        for (int d = 0; d < 64; ++d) Y[(size_t)r * 1024 + br * 256 + h * 64 + d] = f2bf(v[d] * rs * g[d] * silu(bf2f(Z[(size_t)r * ZW + zg + d])));
    }
}

__device__ void ph_attn_naive(const P& p, int bid, int nb, float* lds) {
    const bf16_t* AQ = wsp<bf16_t>(p, WS_AQ); const bf16_t* AK = wsp<bf16_t>(p, WS_AK); const bf16_t* AV = wsp<bf16_t>(p, WS_AV); bf16_t* Y = wsp<bf16_t>(p, WS_Y);
    float* Ks = lds; float* Vs = lds + 64 * 64;
    const int nunits = 4 * (T / 256);
    for (int u = bid; u < nunits; u += nb) {
        const int hq = u / (T / 256), qb = u % (T / 256), hk = hq >> 1, r = qb * 256 + threadIdx.x;
        const int nkeys = qb == 0 ? NC : T;
        float q[64], o[64], m = -1e30f, lsum = 0.f;
#pragma unroll
        for (int d = 0; d < 64; ++d) { q[d] = bf2f(AQ[(size_t)r * 256 + hq * 64 + d]); o[d] = 0.f; }
        for (int k0 = 0; k0 < nkeys; k0 += 64) {
            __syncthreads();
            for (int e = threadIdx.x; e < 64 * 64; e += 256) { const int kk = e >> 6, d = e & 63; Ks[e] = bf2f(AK[(size_t)(k0 + kk) * 128 + hk * 64 + d]); Vs[e] = bf2f(AV[(size_t)(k0 + kk) * 128 + hk * 64 + d]); }
            __syncthreads();
            for (int kk = 0; kk < 64; ++kk) {
                float s = 0.f;
#pragma unroll
                for (int d = 0; d < 64; d += 4) { const f32x4 kv = *(const f32x4*)(Ks + kk * 64 + d); s += q[d] * kv.x + q[d + 1] * kv.y + q[d + 2] * kv.z + q[d + 3] * kv.w; }
                if (s > m) { const float al = exp2f(m - s); lsum *= al;
#pragma unroll
                    for (int d = 0; d < 64; ++d) o[d] *= al;
                    m = s; }
                const float pe = exp2f(s - m); lsum += pe;
#pragma unroll
                for (int d = 0; d < 64; d += 4) { const f32x4 vv = *(const f32x4*)(Vs + kk * 64 + d); o[d] += pe * vv.x; o[d + 1] += pe * vv.y; o[d + 2] += pe * vv.z; o[d + 3] += pe * vv.w; }
            }
        }
        const float il = 1.f / lsum;
#pragma unroll
        for (int d = 0; d < 64; ++d) Y[(size_t)r * 1024 + 512 + hq * 64 + d] = f2bf(o[d] * il);
    }
}

__device__ void ph_g2(const P& p, int bid, int nb, float* lds) {
    const int l = p.layer; const bf16_t* Y = wsp<bf16_t>(p, WS_Y); bf16_t* B = wsp<bf16_t>(p, WS_Z);
    const int ntiles = (T / 32) * 16;
    for (int t = bid; t < ntiles; t += nb) {
        const int r0 = (t / 16) * 32, n4 = (t % 16) / 4, j = ((t % 16) % 4) * 256 + threadIdx.x;
        const float* W = p.in[I_WBR] + ((size_t)l * 4 + n4) * 256 * 1024;
        float acc[32]; ZERO32(acc);
        tile_mac(acc, r0, j, 256, [&](int r, int k) { return bf2f(Y[(size_t)r * 1024 + n4 * 256 + k]); }, [&](int k, int c) { return W[(size_t)k * 1024 + c]; }, lds);
#pragma unroll
        for (int rr = 0; rr < 32; ++rr) B[(size_t)(r0 + rr) * 4096 + n4 * 1024 + j] = f2bf(acc[rr]);
    }
}
__device__ void ph_g3(const P& p, int bid, int nb, float* lds) {
    const int l = p.layer; const bf16_t* H = wsp<bf16_t>(p, WS_H); const bf16_t* B = wsp<bf16_t>(p, WS_Z); bf16_t* M = wsp<bf16_t>(p, WS_M);
    const int ntiles = (T / 32) * 4;
    for (int t = bid; t < ntiles; t += nb) {
        const int r0 = (t / 4) * 32, j = (t % 4) * 256 + threadIdx.x;
        float macc[32]; ZERO32(macc);
        for (int n4 = 0; n4 < 4; ++n4) {
            const float* W = p.in[I_WMG] + ((size_t)l * 4 + n4) * 1024 * 1024;
            float acc[32]; ZERO32(acc);
            tile_mac(acc, r0, j, 1024, [&](int r, int k) { return bf2f(H[(size_t)r * 1024 + k]); }, [&](int k, int c) { return W[(size_t)k * 1024 + c]; }, lds);
#pragma unroll
            for (int rr = 0; rr < 32; ++rr) macc[rr] += sigm(acc[rr]) * bf2f(B[(size_t)(r0 + rr) * 4096 + n4 * 1024 + j]);
        }
#pragma unroll
        for (int rr = 0; rr < 32; ++rr) M[(size_t)(r0 + rr) * 1024 + j] = f2bf(macc[rr]);
    }
}
__device__ void ph_g4(const P& p, int bid, int nb, float* lds) {
    const int l = p.layer; const bf16_t* M = wsp<bf16_t>(p, WS_M); float* YO = wsp<float>(p, WS_YO);
    const float* W = p.in[I_WOUT] + (size_t)l * 1024 * 1024;
    const int ntiles = (T / 32) * 4;
    for (int t = bid; t < ntiles; t += nb) {
        const int r0 = (t / 4) * 32, j = (t % 4) * 256 + threadIdx.x;
        float acc[32]; ZERO32(acc);
        tile_mac(acc, r0, j, 1024, [&](int r, int k) { return bf2f(M[(size_t)r * 1024 + k]); }, [&](int k, int c) { return W[(size_t)k * 1024 + c]; }, lds);
#pragma unroll
        for (int rr = 0; rr < 32; ++rr) YO[(size_t)(r0 + rr) * 1024 + j] = acc[rr];
    }
}

__device__ void ph_rows1(const P& p, int bid, int nb) {
    const int l = p.layer, lane = threadIdx.x & 63, wpb = blockDim.x >> 6;
    const int gw = bid * wpb + (threadIdx.x >> 6), ngw = nb * wpb;
    float* XC = wsp<float>(p, WS_XC); const float* YO = wsp<float>(p, WS_YO); bf16_t* H2 = wsp<bf16_t>(p, WS_H); float* AFF = wsp<float>(p, WS_AFF);
    const float* gpo = p.in[I_GPOM] + l * 1024; const float* gpf = p.in[I_GPF] + l * 1024; const float* wr_ = p.in[I_WRT] + (size_t)l * 1024 * 16;
    for (int r = gw; r < T; r += ngw) {
        const float* mod = wsp<float>(p, WS_MOD) + (l * 2 + (r >= NC ? 1 : 0)) * 6144;
        f32x4 y[4], x[4]; float ss = 0.f;
#pragma unroll
        for (int j = 0; j < 4; ++j) { y[j] = *(const f32x4*)(YO + (size_t)r * 1024 + j * 256 + lane * 4); ss += y[j].x * y[j].x + y[j].y * y[j].y + y[j].z * y[j].z + y[j].w * y[j].w; }
        const float rs = rsqrtf(wave_sum(ss) * (1.f / 1024.f) + EPS);
        float s2 = 0.f;
#pragma unroll
        for (int j = 0; j < 4; ++j) {
            const int k0 = j * 256 + lane * 4; x[j] = *(const f32x4*)(XC + (size_t)r * 1024 + k0);
#pragma unroll
            for (int e = 0; e < 4; ++e) { const int k = k0 + e; x[j][e] += mod[2048 + k] * (y[j][e] * rs * gpo[k]); s2 += x[j][e] * x[j][e]; }
            *(f32x4*)(XC + (size_t)r * 1024 + k0) = x[j];
        }
        const float rs2 = rsqrtf(wave_sum(s2) * (1.f / 1024.f) + EPS);
        float lg[16];
#pragma unroll
        for (int i = 0; i < 16; ++i) lg[i] = 0.f;
#pragma unroll
        for (int j = 0; j < 4; ++j) {
            const int k0 = j * 256 + lane * 4; float h[4];
#pragma unroll
            for (int e = 0; e < 4; ++e) { const int k = k0 + e; h[e] = x[j][e] * rs2 * gpf[k] * (1.f + mod[4096 + k]) + mod[3072 + k]; }
            *(uint2*)(H2 + (size_t)r * 1024 + k0) = make_uint2((unsigned)f2bf(h[0]) | ((unsigned)f2bf(h[1]) << 16), (unsigned)f2bf(h[2]) | ((unsigned)f2bf(h[3]) << 16));
#pragma unroll
            for (int e = 0; e < 4; ++e) {
                const float* wr = wr_ + (size_t)(k0 + e) * 16;
#pragma unroll
                for (int q = 0; q < 4; ++q) { const f32x4 w4 = *(const f32x4*)(wr + q * 4); lg[q * 4 + 0] += h[e] * w4.x; lg[q * 4 + 1] += h[e] * w4.y; lg[q * 4 + 2] += h[e] * w4.z; lg[q * 4 + 3] += h[e] * w4.w; }
            }
        }
        float mx = -1e30f;
#pragma unroll
        for (int i = 0; i < 16; ++i) { lg[i] = wave_sum(lg[i]); mx = fmaxf(mx, lg[i]); }
        float se = 0.f;
#pragma unroll
        for (int i = 0; i < 16; ++i) { lg[i] = expf(lg[i] - mx); se += lg[i]; }
        const float inv = 1.f / se;
#pragma unroll
        for (int i = 0; i < 16; ++i) if (lane == i) AFF[(size_t)r * 16 + i] = lg[i] * inv;
    }
}

__device__ void ph_topk_naive(const P& p, int bid, int nb, float* lds) {
    const float* AFF = wsp<float>(p, WS_AFF); int* INV = wsp<int>(p, WS_INV); int* IDX = wsp<int>(p, WS_IDX); float* VAL = wsp<float>(p, WS_VAL);
    const int gt = bid * blockDim.x + threadIdx.x, ng = nb * blockDim.x;
    const int nunits = NE * (NL / 256) + NE;
    for (int u = bid; u < nunits; u += nb) {
        const bool isctx = u >= NE * (NL / 256);
        const int e = isctx ? u - NE * (NL / 256) : u / (NL / 256), tb = isctx ? 0 : u % (NL / 256);
        const int base = isctx ? 0 : NC, n = isctx ? NC : NL, cap = isctx ? CAP_C : CAP_L, soff = isctx ? CAP_L : 0;
        const int t = tb * 256 + threadIdx.x; const float a = AFF[(size_t)(base + t) * 16 + e];
        int cnt = 0;
        for (int t0 = 0; t0 < n; t0 += 256) {
            __syncthreads(); lds[threadIdx.x] = AFF[(size_t)(base + t0 + threadIdx.x) * 16 + e]; __syncthreads();
#pragma unroll 8
            for (int i = 0; i < 256; ++i) { const float av = lds[i]; cnt += (av > a || (av == a && (t0 + i) < t)) ? 1 : 0; }
        }
        const bool sel = cnt < cap;
        INV[(size_t)(base + t) * 16 + e] = sel ? soff + cnt : -1;
        if (sel) { IDX[e * EROWS + soff + cnt] = base + t; VAL[e * EROWS + soff + cnt] = a; }
    }
    for (int idx = gt; idx < NE * (EROWS - CAP_L - CAP_C); idx += ng) { const int e = idx / (EROWS - CAP_L - CAP_C), s = CAP_L + CAP_C + idx % (EROWS - CAP_L - CAP_C); IDX[e * EROWS + s] = 0; VAL[e * EROWS + s] = 0.f; }
}

__device__ void ph_moe_act(const P& p, int bid, int nb, float* lds) {
    const int l = p.layer; const bf16_t* H2 = wsp<bf16_t>(p, WS_H); const int* IDX = wsp<int>(p, WS_IDX); bf16_t* ACT = wsp<bf16_t>(p, WS_ACT);
    const int rows = CAP_L + CAP_C, rt = rows / 32, ntiles = NE * rt * 4;
    for (int t = bid; t < ntiles; t += nb) {
        const int e = t / (rt * 4), r0 = ((t / 4) % rt) * 32, f = (t % 4) * 256 + threadIdx.x;
        const float* Wg = p.in[I_WEG] + ((size_t)l * NE + e) * 1024 * 1024; const float* Wu = p.in[I_WEU] + ((size_t)l * NE + e) * 1024 * 1024;
        const int* ix = IDX + e * EROWS;
        float ag[32], au[32]; ZERO32(ag); ZERO32(au);
        tile_mac(ag, r0, f, 1024, [&](int r, int k) { return bf2f(H2[(size_t)ix[r] * 1024 + k]); }, [&](int k, int c) { return Wg[(size_t)k * 1024 + c]; }, lds);
        tile_mac(au, r0, f, 1024, [&](int r, int k) { return bf2f(H2[(size_t)ix[r] * 1024 + k]); }, [&](int k, int c) { return Wu[(size_t)k * 1024 + c]; }, lds);
#pragma unroll
        for (int rr = 0; rr < 32; ++rr) ACT[((size_t)e * EROWS + r0 + rr) * 1024 + f] = f2bf(silu(ag[rr]) * au[rr]);
    }
}
__device__ void ph_moe_down(const P& p, int bid, int nb, float* lds) {
    const int l = p.layer; const bf16_t* ACT = wsp<bf16_t>(p, WS_ACT); bf16_t* YE = wsp<bf16_t>(p, WS_YE);
    const int rows = CAP_L + CAP_C, rt = rows / 32, ntiles = NE * rt * 4;
    for (int t = bid; t < ntiles; t += nb) {
        const int e = t / (rt * 4), r0 = ((t / 4) % rt) * 32, d = (t % 4) * 256 + threadIdx.x;
        const float* Wd = p.in[I_WED] + ((size_t)l * NE + e) * 1024 * 1024;
        float acc[32]; ZERO32(acc);
        tile_mac(acc, r0, d, 1024, [&](int r, int k) { return bf2f(ACT[((size_t)e * EROWS + r) * 1024 + k]); }, [&](int k, int c) { return Wd[(size_t)k * 1024 + c]; }, lds);
#pragma unroll
        for (int rr = 0; rr < 32; ++rr) YE[((size_t)e * EROWS + r0 + rr) * 1024 + d] = f2bf(acc[rr]);
    }
}

__device__ void ph_rows2(const P& p, int bid, int nb) {
    const int l = p.layer, lane = threadIdx.x & 63, wpb = blockDim.x >> 6;
    const int gw = bid * wpb + (threadIdx.x >> 6), ngw = nb * wpb;
    float* XC = wsp<float>(p, WS_XC); const bf16_t* YE = wsp<bf16_t>(p, WS_YE); const int* INV = wsp<int>(p, WS_INV); const float* VAL = wsp<float>(p, WS_VAL);
    const float* gpo = p.in[I_GPOF] + l * 1024;
    for (int r = gw; r < T; r += ngw) {
        const float* mod = wsp<float>(p, WS_MOD) + (l * 2 + (r >= NC ? 1 : 0)) * 6144;
        f32x4 f[4];
#pragma unroll
        for (int j = 0; j < 4; ++j) f[j] = (f32x4){0.f, 0.f, 0.f, 0.f};
        for (int e = 0; e < NE; ++e) {
            const int slot = INV[(size_t)r * 16 + e];
            if (slot >= 0) {
                const float v = VAL[e * EROWS + slot]; const bf16_t* ye = YE + ((size_t)e * EROWS + slot) * 1024;
#pragma unroll
                for (int j = 0; j < 4; ++j) { const uint2 w = *(const uint2*)(ye + j * 256 + lane * 4);
                    f[j].x += v * __uint_as_float(w.x << 16); f[j].y += v * __uint_as_float(w.x & 0xffff0000u); f[j].z += v * __uint_as_float(w.y << 16); f[j].w += v * __uint_as_float(w.y & 0xffff0000u); }
            }
        }
        float ss = 0.f;
#pragma unroll
        for (int j = 0; j < 4; ++j) ss += f[j].x * f[j].x + f[j].y * f[j].y + f[j].z * f[j].z + f[j].w * f[j].w;
        const float rs = rsqrtf(wave_sum(ss) * (1.f / 1024.f) + EPS);
#pragma unroll
        for (int j = 0; j < 4; ++j) {
            const int k0 = j * 256 + lane * 4; f32x4 x = *(const f32x4*)(XC + (size_t)r * 1024 + k0);
#pragma unroll
            for (int e = 0; e < 4; ++e) { const int k = k0 + e; x[e] += mod[5120 + k] * (f[j][e] * rs * gpo[k]); }
            *(f32x4*)(XC + (size_t)r * 1024 + k0) = x;
            if (l == 1 && r >= NC) *(f32x4*)(p.out + (size_t)(r - NC) * 1024 + k0) = x;
        }
    }
}

enum { PH_PRO = 0, PH_ROWS0, PH_G1, PH_MIXPREP, PH_RECUR, PH_HEADNORM, PH_ATTN, PH_G2, PH_G3, PH_G4, PH_ROWS1, PH_TOPK, PH_MOEACT, PH_MOEDOWN, PH_ROWS2 };
template <int PH> __global__ void __launch_bounds__(256) k_phase(P p) {
    __shared__ __attribute__((aligned(16))) float lds[64 * 64 * 2];
    const int bid = blockIdx.x, nb = gridDim.x;
    if (PH == PH_PRO) ph_prologue(p, bid, nb);
    if (PH == PH_ROWS0) ph_rows0(p, bid, nb);
    if (PH == PH_G1) ph_g1(p, bid, nb, lds);
    if (PH == PH_MIXPREP) ph_mixprep(p, bid, nb);
    if (PH == PH_HEADNORM) ph_headnorm(p, bid, nb);
    if (PH == PH_ATTN) ph_attn_naive(p, bid, nb, lds);
    if (PH == PH_G2) ph_g2(p, bid, nb, lds);
    if (PH == PH_G3) ph_g3(p, bid, nb, lds);
    if (PH == PH_G4) ph_g4(p, bid, nb, lds);
    if (PH == PH_ROWS1) ph_rows1(p, bid, nb);
    if (PH == PH_TOPK) ph_topk_naive(p, bid, nb, lds);
    if (PH == PH_MOEACT) ph_moe_act(p, bid, nb, lds);
    if (PH == PH_MOEDOWN) ph_moe_down(p, bid, nb, lds);
    if (PH == PH_ROWS2) ph_rows2(p, bid, nb);
}
__global__ void __launch_bounds__(64) k_recur(P p) { ph_recur_naive(p, blockIdx.x); }

extern "C" void kernel_launch(void* const* d_in, const int* in_sizes, int n_in, void* d_out, int out_size, void* d_ws, size_t ws_size, hipStream_t stream) {
    if (n_in != N_IN || ws_size < WS_END || out_size != NL * D) { fprintf(stderr, "kernel_launch: unexpected sizes n_in %d ws %zu out %d\n", n_in, ws_size, out_size); return; }
    P p{};
    for (int i = 0; i < N_IN; ++i) p.in[i] = (const float*)d_in[i];
    p.out = (float*)d_out; p.ws = (unsigned char*)d_ws;
    const int G = 2048;
    p.layer = 0;
    k_phase<PH_PRO><<<G, 256, 0, stream>>>(p);
    for (int l = 0; l < 2; ++l) {
        p.layer = l;
        k_phase<PH_ROWS0><<<G, 256, 0, stream>>>(p);
        k_phase<PH_G1><<<G, 256, 0, stream>>>(p);
        k_phase<PH_MIXPREP><<<G, 256, 0, stream>>>(p);
        k_recur<<<24, 64, 0, stream>>>(p);
        k_phase<PH_ATTN><<<4 * (T / 256), 256, 0, stream>>>(p);
        k_phase<PH_HEADNORM><<<G, 256, 0, stream>>>(p);
        k_phase<PH_G2><<<G, 256, 0, stream>>>(p);
        k_phase<PH_G3><<<G, 256, 0, stream>>>(p);
        k_phase<PH_G4><<<G, 256, 0, stream>>>(p);
        k_phase<PH_ROWS1><<<G, 256, 0, stream>>>(p);
        k_phase<PH_TOPK><<<NE * (NL / 256) + NE, 256, 0, stream>>>(p);
        k_phase<PH_MOEACT><<<G, 256, 0, stream>>>(p);
        k_phase<PH_MOEDOWN><<<G, 256, 0, stream>>>(p);
        k_phase<PH_ROWS2><<<G, 256, 0, stream>>>(p);
    }
}
```

```cpp
#include <hip/hip_runtime.h>
#include <hip/hip_cooperative_groups.h>
#include <cstdio>
#include <cstdint>

namespace cg = cooperative_groups;
#define DEV __device__ __forceinline__
#define LAS __attribute__((address_space(3)))
typedef unsigned short bf16_t;
typedef float f32x4 __attribute__((ext_vector_type(4)));

constexpr int NC = 256, NL = 16384, T = NC + NL, D = 1024, DIN = 3856, ZW = 3840, GW = 64;
constexpr int NE = 16, CAP_L = 2048, CAP_C = 32, EROWS = 2304;
constexpr float EPS = 1e-6f;
constexpr float C2 = 0.125f * 1.4426950408889634f;
constexpr int ZC_RQ = 0, ZC_RK = 256, ZC_RV = 512, ZC_RG = 768, ZC_HQ = 1024, ZC_HFF = 1280, ZC_HFB = 1536, ZC_HI = 1792, ZC_HG = 2048,
              ZC_AQ = 2304, ZC_AK = 2560, ZC_AV = 2688, ZC_GQ = 2816, ZC_GK = 3072, ZC_GV = 3328, ZC_GG = 3584;
enum { I_X = 0, I_C, I_CTX, I_CCTX, I_WADA, I_BADA, I_GPM, I_GPOM, I_GPF, I_GPOF, I_WIN, I_RNG, I_LBL, I_HNG, I_AQG, I_AKG, I_CONV, I_ALOG, I_DTB, I_GNG,
       I_WBR, I_WMG, I_WOUT, I_WRT, I_WEG, I_WEU, I_WED, N_IN };

constexpr size_t MiB = 1u << 20;
constexpr size_t WS_MOD = 1 * MiB;
constexpr size_t WS_LB = WS_MOD + 128 * 1024;
constexpr size_t WS_ROPE = WS_LB + 8 * 1024;
constexpr size_t WS_GATE = 2 * MiB;
constexpr size_t WS_AFF = 4 * MiB;
constexpr size_t WS_INV = 6 * MiB;
constexpr size_t WS_IDX = 8 * MiB;
constexpr size_t WS_VAL = WS_IDX + 256 * 1024;
constexpr size_t WS_XC = 16 * MiB;
constexpr size_t WS_H = 81 * MiB;
constexpr size_t WS_Y = 114 * MiB;
constexpr size_t WS_M = 147 * MiB;
constexpr size_t WS_YO = 180 * MiB;
constexpr size_t WS_Z = 245 * MiB;
constexpr size_t WS_XE = 245 * MiB;
constexpr size_t WS_YE = 317 * MiB;
constexpr size_t WS_ACT = 114 * MiB;
constexpr size_t WS_GQKV = 147 * MiB;
constexpr size_t WS_AQ = 172 * MiB;
constexpr size_t WS_AK = 181 * MiB;
constexpr size_t WS_AV = 186 * MiB;
constexpr size_t WS_END = 555 * MiB;

struct P {
    const float* in[N_IN];
    float* out;
    unsigned char* ws;
    int pad0, pad1;
};

DEV float bf2f(bf16_t v) { return __uint_as_float(((unsigned)v) << 16); }
DEV bf16_t f2bf(float f) { unsigned u = __float_as_uint(f); u += 0x7fffu + ((u >> 16) & 1u); return (bf16_t)(u >> 16); }
DEV float sigm(float x) { return 1.f / (1.f + expf(-x)); }
DEV float silu(float x) { return x / (1.f + expf(-x)); }
DEV float pg_fsigm(float x) { return __builtin_amdgcn_rcpf(1.f + __builtin_amdgcn_exp2f(-1.4426950408889634f * x)); }
#define RL(x, d) __int_as_float(__builtin_amdgcn_readlane(__float_as_int(x), (d)))
#define SWZ_XOR(v, pat) __int_as_float(__builtin_amdgcn_ds_swizzle(__float_as_int(v), (pat)))
#define USWZ(v, pat) ((unsigned)__builtin_amdgcn_ds_swizzle((int)(v), (pat)))
DEV float wave_sum(float v) {
    v += SWZ_XOR(v, 0x041F); v += SWZ_XOR(v, 0x081F); v += SWZ_XOR(v, 0x101F); v += SWZ_XOR(v, 0x201F); v += SWZ_XOR(v, 0x401F);
    const auto rr = __builtin_amdgcn_permlane32_swap(__float_as_uint(v), __float_as_uint(v), false, false);
    return __uint_as_float(rr[0]) + __uint_as_float(rr[1]);
}
struct PV {
    const P& a; unsigned z; int wv;
    DEV int tid() const { return wv * 64 + (int)__builtin_amdgcn_mbcnt_hi(~0u, __builtin_amdgcn_mbcnt_lo(~0u, z)); }
    DEV const float* inp(int i) const { return (const float*)((const char*)a.in[i] + z); }
    DEV float* outp() const { return (float*)((char*)a.out + z); }
    DEV unsigned char* wsb() const { return a.ws + z; }
};
template <class Tp> DEV Tp* wsp(const PV& p, size_t off) { return (Tp*)(p.wsb() + off); }

#define TIDX (p.tid())
constexpr int NTHREADS_C = 512;
DEV void ph_prologue(const PV& p, const int l, int bid, int nb, LAS unsigned char* lds3) {
    const int gt = bid * blockDim.x + TIDX, ng = nb * blockDim.x;
    {
        float* MOD = wsp<float>(p, WS_MOD); LAS float* sl = (LAS float*)lds3; LAS float* red = sl + 2048;
        const int tid = TIDX, lane = tid & 63, wave = p.wv;
        for (int i = tid; i < 2048; i += NTHREADS_C) { const float x = (i < 1024 ? p.inp(I_CCTX) : p.inp(I_C))[i & 1023]; sl[i] = silu(x); }
        __syncthreads();
        for (int it = bid; it < 2 * 96; it += nb) { const int l = it / 96, j = (it % 96) * 64 + lane;
            const float* wa = p.inp(I_WADA) + ((size_t)l * 1024 + wave * 128) * 6144 + j;
            float a0 = 0.f, a1 = 0.f;
#pragma unroll 16
            for (int k = 0; k < 128; ++k) { const float w = wa[(size_t)k * 6144]; a0 += sl[wave * 128 + k] * w; a1 += sl[1024 + wave * 128 + k] * w; }
            red[(wave * 2 + 0) * 64 + lane] = a0; red[(wave * 2 + 1) * 64 + lane] = a1;
            __syncthreads();
            if (wave < 2) { float t = p.inp(I_BADA)[l * 6144 + j];
#pragma unroll
                for (int w8 = 0; w8 < 8; ++w8) t += red[(w8 * 2 + wave) * 64 + lane];
                MOD[(l * 2 + wave) * 6144 + j] = t; }
            __syncthreads();
        }
    }
    float* LB = wsp<float>(p, WS_LB);
    for (int idx = gt; idx < 2 * 2 * 256; idx += ng) {
        const int dir = idx / 512, l = (idx / 256) & 1, i = idx % 256;
        const float l0 = p.inp(I_LBL)[(dir * 2 + 0) * 256 + i], l1 = p.inp(I_LBL)[(dir * 2 + 1) * 256 + i];
        LB[idx] = l ? 1.f / (1.f + expf(l0 - l1)) : 0.f;
    }
    float* RC = wsp<float>(p, WS_ROPE);
    for (int idx = gt; idx < 256 * 16; idx += ng) {
        const int pos = idx / 16, j = idx % 16;
        const double inv = pow(10000.0, -(double)j / 16.0), a = (double)pos * inv;
        RC[idx] = (float)cos(a); RC[4096 + idx] = (float)sin(a);
    }
}

DEV void stage_table16(LAS float* tab, const float* src, const size_t ld, const int tid) {
    for (int i = tid; i < 4096; i += NTHREADS_C) { const int k = i >> 2, q = i & 3, j = k >> 8, L = (k >> 2) & 63, e = k & 3;
        *(LAS f32x4*)(tab + ((j * 4 + e) * 64 + L) * 20 + q * 4) = *(const f32x4*)(src + (size_t)k * ld + q * 4); }
    __syncthreads();
}
DEV void dot16(float (&acc)[16], const f32x4 (&h)[4], LAS const float* tab, const int lane) {
#pragma unroll
    for (int j = 0; j < 4; ++j)
#pragma unroll
        for (int e = 0; e < 4; ++e) { const float he = h[j][e]; LAS const float* t = tab + ((j * 4 + e) * 64 + lane) * 20;
#pragma unroll
            for (int q = 0; q < 4; ++q) { const f32x4 w = *(LAS const f32x4*)(t + q * 4); acc[q * 4 + 0] += he * w.x; acc[q * 4 + 1] += he * w.y; acc[q * 4 + 2] += he * w.z; acc[q * 4 + 3] += he * w.w; }
            if (e & 1) __builtin_amdgcn_sched_barrier(0);
        }
}
DEV int idx16(const int lane) { return ((lane >> 4) & 1) * 8 + ((lane >> 3) & 1) * 4 + ((lane >> 2) & 1) * 2 + ((lane >> 1) & 1); }
DEV float selm(const unsigned m, const float a, const float b) { return __uint_as_float((__float_as_uint(a) & m) | (__float_as_uint(b) & ~m)); }
DEV float reduce16(const float (&v)[16], const int lane) {
    const unsigned m4 = 0u - ((lane >> 4) & 1), m3 = 0u - ((lane >> 3) & 1), m2 = 0u - ((lane >> 2) & 1), m1 = 0u - ((lane >> 1) & 1);
    float a[8], b[4], c[2];
#pragma unroll
    for (int i = 0; i < 8; ++i) a[i] = selm(m4, v[i + 8], v[i]) + SWZ_XOR(selm(m4, v[i], v[i + 8]), 0x401F);
#pragma unroll
    for (int i = 0; i < 4; ++i) b[i] = selm(m3, a[i + 4], a[i]) + SWZ_XOR(selm(m3, a[i], a[i + 4]), 0x201F);
#pragma unroll
    for (int i = 0; i < 2; ++i) c[i] = selm(m2, b[i + 2], b[i]) + SWZ_XOR(selm(m2, b[i], b[i + 2]), 0x101F);
    float d = selm(m1, c[1], c[0]) + SWZ_XOR(selm(m1, c[0], c[1]), 0x081F);
    d += SWZ_XOR(d, 0x041F);
    const auto rr = __builtin_amdgcn_permlane32_swap(__float_as_uint(d), __float_as_uint(d), false, false);
    return __uint_as_float(rr[0]) + __uint_as_float(rr[1]);
}
DEV float max16(float v) { v = fmaxf(v, SWZ_XOR(v, 0x081F)); v = fmaxf(v, SWZ_XOR(v, 0x101F)); v = fmaxf(v, SWZ_XOR(v, 0x201F)); v = fmaxf(v, SWZ_XOR(v, 0x401F)); return v; }
DEV float sum16(float v) { v += SWZ_XOR(v, 0x081F); v += SWZ_XOR(v, 0x101F); v += SWZ_XOR(v, 0x201F); v += SWZ_XOR(v, 0x401F); return v; }
DEV float dot4(const f32x4 v) { return v.x * v.x + v.y * v.y + v.z * v.z + v.w * v.w; }
DEV uint2 pack4(const f32x4 h) { return make_uint2((unsigned)f2bf(h.x) | ((unsigned)f2bf(h.y) << 16), (unsigned)f2bf(h.z) | ((unsigned)f2bf(h.w) << 16)); }

DEV void rows0_core(const PV& p, const int r, const int lane, const f32x4 (&x)[4], const f32x4 (&gs)[4], const f32x4 (&sh)[4], LAS const float* tab) {
    bf16_t* H = wsp<bf16_t>(p, WS_H); float* GATE = wsp<float>(p, WS_GATE);
    float ss = 0.f;
#pragma unroll
    for (int j = 0; j < 4; ++j) ss += dot4(x[j]);
    const float rstd = rsqrtf(wave_sum(ss) * (1.f / 1024.f) + EPS);
    f32x4 h[4];
#pragma unroll
    for (int j = 0; j < 4; ++j) { h[j] = x[j] * rstd * gs[j] + sh[j]; *(uint2*)(H + (size_t)r * 1024 + j * 256 + lane * 4) = pack4(h[j]); }
    float ga[16];
#pragma unroll
    for (int i = 0; i < 16; ++i) ga[i] = 0.f;
    dot16(ga, h, tab, lane);
    const float s = reduce16(ga, lane);
    if ((lane & 33) == 0) GATE[(size_t)r * 16 + idx16(lane)] = s;
}
DEV void ph_rows0(const PV& p, const int l, int bid, int nb, LAS unsigned char* lds3) {
    const int tid = TIDX, lane = tid & 63, wpb = blockDim.x >> 6;
    const int gw = bid * wpb + p.wv, ngw = nb * wpb;
    LAS float* tab = (LAS float*)lds3;
    stage_table16(tab, p.inp(I_WIN) + (size_t)l * 1024 * DIN + 3584, DIN, tid);
    const float* g = p.inp(I_GPM) + l * 1024;
#pragma unroll 1
    for (int seg = 0; seg < 2; ++seg) {
        const float* mod = wsp<float>(p, WS_MOD) + (l * 2 + seg) * 6144;
        const float* XI = l ? wsp<float>(p, WS_XC) : (seg ? p.inp(I_X) - (size_t)NC * 1024 : p.inp(I_CTX));
        f32x4 gs[4], sh[4];
#pragma unroll
        for (int j = 0; j < 4; ++j) { const int k0 = j * 256 + lane * 4; gs[j] = *(const f32x4*)(g + k0) * (1.f + *(const f32x4*)(mod + 1024 + k0)); sh[j] = *(const f32x4*)(mod + k0); }
        const int r0 = seg ? NC + gw : gw, rend = seg ? T : NC;
        f32x4 xn[4];
        if (r0 < rend) {
#pragma unroll
            for (int j = 0; j < 4; ++j) xn[j] = *(const f32x4*)(XI + (size_t)r0 * 1024 + j * 256 + lane * 4);
        }
        for (int r = r0; r < rend; r += ngw) {
            f32x4 x[4];
#pragma unroll
            for (int j = 0; j < 4; ++j) x[j] = xn[j];
            const int rn = r + ngw;
            if (rn < rend) {
#pragma unroll
                for (int j = 0; j < 4; ++j) xn[j] = *(const f32x4*)(XI + (size_t)rn * 1024 + j * 256 + lane * 4);
            }
            rows0_core(p, r, lane, x, gs, sh, tab);
        }
    }
}

typedef unsigned u32x4_t __attribute__((ext_vector_type(4)));
DEV void ph_mixprep(const PV& p, const int l, int bid, int nb) {
    const int tid = TIDX, lane = tid & 63, sub = lane & 7, tsk = lane >> 3;
    const bf16_t* Z = wsp<bf16_t>(p, WS_Z); const float* RC = wsp<float>(p, WS_ROPE);
    bf16_t* AQ = wsp<bf16_t>(p, WS_AQ); bf16_t* AK = wsp<bf16_t>(p, WS_AK); bf16_t* AV = wsp<bf16_t>(p, WS_AV); bf16_t* GQKV = wsp<bf16_t>(p, WS_GQKV);
    const int gw = bid * 8 + p.wv - 64, ngw = nb * 8 - 64;
    if (gw < 0) return;
    {
        const bool isq = tsk < 4, isn = tsk < 6, hi = (sub & 2) != 0;
        const int zc = (isq ? ZC_AQ + tsk * 64 : (isn ? ZC_AK + (tsk - 4) * 64 : ZC_AV + (tsk - 6) * 64)) + sub * 8;
        const float* gp = (isq ? p.inp(I_AQG) : p.inp(I_AKG)) + l * 64 + sub * 8;
        float g[8];
#pragma unroll
        for (int e = 0; e < 8; ++e) g[e] = isn ? gp[e] * (isq ? C2 : 1.f) : 1.f;
        bf16_t* dbase = isq ? AQ + tsk * 64 + sub * 8 : (isn ? AK + (tsk - 4) * 64 + sub * 8 : AV + (tsk - 6) * 64 + sub * 8); const int dp = isq ? 256 : 128;
        for (int r0 = gw; r0 < T; r0 += 2 * ngw) {
            const bool has1 = r0 + ngw < T; const int rr[2] = {r0, has1 ? r0 + ngw : r0};
            u32x4_t w[2]; f32x4 cs[2][4];
#pragma unroll
            for (int k = 0; k < 2; ++k) { const int r = rr[k]; w[k] = *(const u32x4_t*)(Z + (size_t)r * ZW + zc);
                const int tl = r >= NC ? r - NC : 0, pos = (sub >= 4) ? (tl % GW) : (tl / GW); const float* c = RC + pos * 16 + (sub & 1) * 8;
                cs[k][0] = *(const f32x4*)c; cs[k][1] = *(const f32x4*)(c + 4); cs[k][2] = *(const f32x4*)(c + 4096); cs[k][3] = *(const f32x4*)(c + 4100); }
#pragma unroll
            for (int k = 0; k < 2; ++k) {
                float f[8] = {__uint_as_float(w[k].x << 16), __uint_as_float(w[k].x & 0xffff0000u), __uint_as_float(w[k].y << 16), __uint_as_float(w[k].y & 0xffff0000u),
                              __uint_as_float(w[k].z << 16), __uint_as_float(w[k].z & 0xffff0000u), __uint_as_float(w[k].w << 16), __uint_as_float(w[k].w & 0xffff0000u)};
                float ss = 0.f;
#pragma unroll
                for (int e = 0; e < 8; ++e) ss += f[e] * f[e];
                ss += SWZ_XOR(ss, 0x041F); ss += SWZ_XOR(ss, 0x081F); ss += SWZ_XOR(ss, 0x101F);
                const float rs = isn ? rsqrtf(ss * (1.f / 64.f) + EPS) : 1.f;
#pragma unroll
                for (int e = 0; e < 8; ++e) { f[e] = f[e] * rs * g[e];
                    const float pr = SWZ_XOR(f[e], 0x081F);
                    const float c = isn ? cs[k][e >> 2][e & 3] : 1.f, sn = isn ? cs[k][2 + (e >> 2)][e & 3] : 0.f;
                    f[e] = hi ? f[e] * c + pr * sn : f[e] * c - pr * sn; }
                if (k == 0 || has1) { u32x4_t o; o.x = (unsigned)f2bf(f[0]) | ((unsigned)f2bf(f[1]) << 16); o.y = (unsigned)f2bf(f[2]) | ((unsigned)f2bf(f[3]) << 16);
                    o.z = (unsigned)f2bf(f[4]) | ((unsigned)f2bf(f[5]) << 16); o.w = (unsigned)f2bf(f[6]) | ((unsigned)f2bf(f[7]) << 16); *(u32x4_t*)(dbase + (size_t)rr[k] * dp) = o; }
            }
        }
    }
    {
        for (int i0 = gw; i0 < T * 12 / 8; i0 += 2 * ngw) {
            const bool has1 = i0 + ngw < T * 12 / 8; const int ii[2] = {i0, has1 ? i0 + ngw : i0};
            u32x4_t z[2][3]; f32x4 cw[2][3][2]; int rk[2], wk[2], hk[2];
#pragma unroll
            for (int k = 0; k < 2; ++k) { const int gt = ii[k] * 8 + tsk, r = gt / 12, tk = gt % 12, which = tk >> 2, h = tk & 3, ch = which * 256 + h * 64 + sub * 8;
                rk[k] = r; wk[k] = which; hk[k] = h;
                const bool first = (r == 0 || r == NC), last = (r == NC - 1 || r == T - 1);
                const bf16_t* zp = Z + (size_t)r * ZW + ZC_GQ + ch; const float* cp = p.inp(I_CONV) + (size_t)l * 3 * 768 + ch;
                z[k][0] = *(const u32x4_t*)(first ? zp : zp - ZW); z[k][1] = *(const u32x4_t*)zp; z[k][2] = *(const u32x4_t*)(last ? zp : zp + ZW);
                const float m0 = first ? 0.f : 1.f, m2 = last ? 0.f : 1.f;
#pragma unroll
                for (int hh = 0; hh < 2; ++hh) { cw[k][0][hh] = *(const f32x4*)(cp + 4 * hh) * m0; cw[k][1][hh] = *(const f32x4*)(cp + 768 + 4 * hh); cw[k][2][hh] = *(const f32x4*)(cp + 1536 + 4 * hh) * m2; } }
#pragma unroll
            for (int k = 0; k < 2; ++k) {
                float a[8];
#pragma unroll
                for (int e = 0; e < 8; ++e) a[e] = 0.f;
#pragma unroll
                for (int t = 0; t < 3; ++t) { const u32x4_t w = z[k][t];
                    const float f[8] = {__uint_as_float(w.x << 16), __uint_as_float(w.x & 0xffff0000u), __uint_as_float(w.y << 16), __uint_as_float(w.y & 0xffff0000u),
                                        __uint_as_float(w.z << 16), __uint_as_float(w.z & 0xffff0000u), __uint_as_float(w.w << 16), __uint_as_float(w.w & 0xffff0000u)};
#pragma unroll
                    for (int e = 0; e < 8; ++e) a[e] += f[e] * cw[k][t][e >> 2][e & 3]; }
                float ss = 0.f, f[8];
#pragma unroll
                for (int e = 0; e < 8; ++e) { f[e] = a[e] * pg_fsigm(a[e]); ss += f[e] * f[e]; }
                ss += SWZ_XOR(ss, 0x041F); ss += SWZ_XOR(ss, 0x081F); ss += SWZ_XOR(ss, 0x101F);
                const float rs = wk[k] < 2 ? rsqrtf(ss + EPS) * (wk[k] == 0 ? 0.125f : 1.f) : 1.f;
#pragma unroll
                for (int e = 0; e < 8; ++e) f[e] *= rs;
                if (k == 0 || has1) { u32x4_t o; o.x = (unsigned)f2bf(f[0]) | ((unsigned)f2bf(f[1]) << 16); o.y = (unsigned)f2bf(f[2]) | ((unsigned)f2bf(f[3]) << 16);
                    o.z = (unsigned)f2bf(f[4]) | ((unsigned)f2bf(f[5]) << 16); o.w = (unsigned)f2bf(f[6]) | ((unsigned)f2bf(f[7]) << 16);
                    *(u32x4_t*)(GQKV + ((size_t)wk[k] * T + rk[k]) * 256 + hk[k] * 64 + sub * 8) = o; }
            }
        }
    }
}

DEV void ph_rows1(const PV& p, const int l, int bid, int nb, LAS unsigned char* lds3) {
    const int tid = TIDX, lane = tid & 63, wpb = blockDim.x >> 6;
    const int gw = bid * wpb + p.wv, ngw = nb * wpb;
    LAS float* tab = (LAS float*)lds3;
    stage_table16(tab, p.inp(I_WRT) + (size_t)l * 1024 * 16, 16, tid);
    float* XC = wsp<float>(p, WS_XC); const float* YO = wsp<float>(p, WS_YO); bf16_t* H2 = wsp<bf16_t>(p, WS_H); float* AFF = wsp<float>(p, WS_AFF);
    const float* gpo = p.inp(I_GPOM) + l * 1024; const float* gpf = p.inp(I_GPF) + l * 1024;
#pragma unroll 1
    for (int seg = l ? 1 : 0; seg < 2; ++seg) {
        const float* mod = wsp<float>(p, WS_MOD) + (l * 2 + seg) * 6144;
        const float* XI = l ? (const float*)XC : (seg ? p.inp(I_X) - (size_t)NC * 1024 : p.inp(I_CTX));
        f32x4 gg[4], gf[4], sh[4];
#pragma unroll
        for (int j = 0; j < 4; ++j) { const int k0 = j * 256 + lane * 4;
            gg[j] = *(const f32x4*)(mod + 2048 + k0) * *(const f32x4*)(gpo + k0); gf[j] = *(const f32x4*)(gpf + k0) * (1.f + *(const f32x4*)(mod + 4096 + k0)); sh[j] = *(const f32x4*)(mod + 3072 + k0); }
        const int r0 = seg ? NC + gw : gw, rend = seg ? T : NC;
        f32x4 yn[4], xn[4];
        if (r0 < rend) {
#pragma unroll
            for (int j = 0; j < 4; ++j) { yn[j] = *(const f32x4*)(YO + (size_t)r0 * 1024 + j * 256 + lane * 4); xn[j] = *(const f32x4*)(XI + (size_t)r0 * 1024 + j * 256 + lane * 4); }
        }
        for (int r = r0; r < rend; r += ngw) {
            f32x4 y[4], x[4];
#pragma unroll
            for (int j = 0; j < 4; ++j) { y[j] = yn[j]; x[j] = xn[j]; }
            const int rn = r + ngw;
            if (rn < rend) {
#pragma unroll
                for (int j = 0; j < 4; ++j) { yn[j] = *(const f32x4*)(YO + (size_t)rn * 1024 + j * 256 + lane * 4); xn[j] = *(const f32x4*)(XI + (size_t)rn * 1024 + j * 256 + lane * 4); }
            }
            float ss = 0.f;
#pragma unroll
            for (int j = 0; j < 4; ++j) ss += dot4(y[j]);
            const float rs = rsqrtf(wave_sum(ss) * (1.f / 1024.f) + EPS);
            float s2 = 0.f;
#pragma unroll
            for (int j = 0; j < 4; ++j) { x[j] += gg[j] * (y[j] * rs); s2 += dot4(x[j]); *(f32x4*)(XC + (size_t)r * 1024 + j * 256 + lane * 4) = x[j]; }
            const float rs2 = rsqrtf(wave_sum(s2) * (1.f / 1024.f) + EPS);
            f32x4 h[4];
#pragma unroll
            for (int j = 0; j < 4; ++j) { h[j] = x[j] * rs2 * gf[j] + sh[j]; *(uint2*)(H2 + (size_t)r * 1024 + j * 256 + lane * 4) = pack4(h[j]); }
            float lg[16];
#pragma unroll
            for (int i = 0; i < 16; ++i) lg[i] = 0.f;
            dot16(lg, h, tab, lane);
            const float v = reduce16(lg, lane);
            const float ex = expf(v - max16(v));
            const float se = sum16(ex);
            if ((lane & 33) == 0) AFF[(size_t)r * 16 + idx16(lane)] = ex / se;
        }
    }
}

DEV void rows2_issue(const bf16_t* YE, const float* VAL, const float* XC, const int r, const int lane, const int sl, float& vl, uint2 (&ye)[4][4], f32x4 (&x)[4]) {
    const int sc = sl < 0 ? 0 : sl;
    const float vv = VAL[(lane & 15) * EROWS + sc];
    vl = sl < 0 ? 0.f : vv;
    unsigned m = (unsigned)__builtin_amdgcn_ballot_w64(sl >= 0) & 0xffffu;
#pragma unroll
    for (int i = 0; i < 4; ++i) {
        if (m) { const int e = __builtin_ctz(m); m &= m - 1; const int slot = __builtin_amdgcn_readlane(sl, e);
            const bf16_t* yr = YE + ((size_t)e * EROWS + slot) * 1024 + lane * 4;
#pragma unroll
            for (int j = 0; j < 4; ++j) ye[i][j] = *(const uint2*)(yr + j * 256);
        }
    }
#pragma unroll
    for (int j = 0; j < 4; ++j) x[j] = *(const f32x4*)(XC + (size_t)r * 1024 + j * 256 + lane * 4);
}
DEV void acc_ye(f32x4& f, const float v, const uint2 w) { f.x += v * __uint_as_float(w.x << 16); f.y += v * __uint_as_float(w.x & 0xffff0000u); f.z += v * __uint_as_float(w.y << 16); f.w += v * __uint_as_float(w.y & 0xffff0000u); }
DEV void ph_rows2(const PV& p, const int l, int bid, int nb, LAS unsigned char* lds3) {
    const int tid = TIDX, lane = tid & 63, wpb = blockDim.x >> 6;
    const int gw = bid * wpb + p.wv, ngw = nb * wpb;
    LAS float* tab = (LAS float*)lds3;
    if (l == 0) stage_table16(tab, p.inp(I_WIN) + (size_t)1 * 1024 * DIN + 3584, DIN, tid);
    float* XC = wsp<float>(p, WS_XC); const bf16_t* YE = wsp<bf16_t>(p, WS_YE); const int* INV = wsp<int>(p, WS_INV); const float* VAL = wsp<float>(p, WS_VAL);
    const float* gpo = p.inp(I_GPOF) + l * 1024; const float* g1 = p.inp(I_GPM) + 1024;
#pragma unroll 1
    for (int seg = l ? 1 : 0; seg < 2; ++seg) {
        const float* mod = wsp<float>(p, WS_MOD) + (l * 2 + seg) * 6144; const float* mod1 = wsp<float>(p, WS_MOD) + (2 + seg) * 6144;
        f32x4 gg[4], gs[4], sh[4];
#pragma unroll
        for (int j = 0; j < 4; ++j) { const int k0 = j * 256 + lane * 4;
            gg[j] = *(const f32x4*)(mod + 5120 + k0) * *(const f32x4*)(gpo + k0);
            if (l == 0) { gs[j] = *(const f32x4*)(g1 + k0) * (1.f + *(const f32x4*)(mod1 + 1024 + k0)); sh[j] = *(const f32x4*)(mod1 + k0); } }
        const int r0 = seg ? NC + gw : gw, rend = seg ? T : NC;
        int slc = -1, sln = -1; float vlc = 0.f; uint2 yec[4][4]; f32x4 xc[4];
        if (r0 < rend) {
            slc = INV[(size_t)r0 * 16 + (lane & 15)];
            if (r0 + ngw < rend) sln = INV[(size_t)(r0 + ngw) * 16 + (lane & 15)];
            rows2_issue(YE, VAL, XC, r0, lane, slc, vlc, yec, xc);
        }
        for (int r = r0; r < rend; r += ngw) {
            const int sl = slc; const float vl = vlc; uint2 ye[4][4]; f32x4 x[4];
#pragma unroll
            for (int i = 0; i < 4; ++i)
#pragma unroll
                for (int j = 0; j < 4; ++j) ye[i][j] = yec[i][j];
#pragma unroll
            for (int j = 0; j < 4; ++j) x[j] = xc[j];
            const int rn = r + ngw;
            if (rn < rend) {
                slc = sln;
                if (rn + ngw < rend) sln = INV[(size_t)(rn + ngw) * 16 + (lane & 15)];
                rows2_issue(YE, VAL, XC, rn, lane, slc, vlc, yec, xc);
            }
            f32x4 f[4];
#pragma unroll
            for (int j = 0; j < 4; ++j) { const float zf = __uint_as_float(p.z); f[j] = (f32x4){zf, zf, zf, zf}; }
            unsigned m = (unsigned)__builtin_amdgcn_ballot_w64(sl >= 0) & 0xffffu;
#pragma unroll
            for (int i = 0; i < 4; ++i) {
                if (m) { const int e = __builtin_ctz(m); m &= m - 1; const float v = RL(vl, e);
#pragma unroll
                    for (int j = 0; j < 4; ++j) acc_ye(f[j], v, ye[i][j]);
                }
            }
            while (m) { const int e = __builtin_ctz(m); m &= m - 1; const float v = RL(vl, e); const int slot = __builtin_amdgcn_readlane(sl, e);
                const bf16_t* yr = YE + ((size_t)e * EROWS + slot) * 1024 + lane * 4;
#pragma unroll
                for (int j = 0; j < 4; ++j) acc_ye(f[j], v, *(const uint2*)(yr + j * 256));
            }
            float ss = 0.f;
#pragma unroll
            for (int j = 0; j < 4; ++j) ss += dot4(f[j]);
            const float rs = rsqrtf(wave_sum(ss) * (1.f / 1024.f) + EPS);
#pragma unroll
            for (int j = 0; j < 4; ++j) { x[j] += gg[j] * (f[j] * rs);
                if (l == 0) *(f32x4*)(XC + (size_t)r * 1024 + j * 256 + lane * 4) = x[j]; else *(f32x4*)(p.outp() + (size_t)(r - NC) * 1024 + j * 256 + lane * 4) = x[j]; }
            if (l == 0) rows0_core(p, r, lane, x, gs, sh, tab);
        }
    }
}

namespace pg {
typedef short bf16x8 __attribute__((ext_vector_type(8)));
typedef unsigned u32x4 __attribute__((ext_vector_type(4)));
typedef unsigned u32x2 __attribute__((ext_vector_type(2)));
constexpr int BM = 256, BK = 64, HALF = 128, HTB = HALF * BK * 2, STAGE_BYTES = 8 * HTB, NXCD = 8, WGM = 8;
DEV int lds_byte(int r, int c) { const int st = (r >> 4) * 2 + (c >> 5), rr = r & 15, cc = c & 31, ob = rr * 64 + cc * 2; return st * 1024 + (ob ^ (((ob >> 9) & 1) << 5)); }
DEV void stage_rc(int b, int& R, int& C) { const int st = b / 1024, sb = b % 1024, swz = sb ^ (((sb >> 9) & 1) << 5); R = (st >> 1) * 16 + swz / 64; C = (st & 1) * 32 + (swz % 64) / 2; }
DEV int perm32(int rho) { const int n = rho >> 4, i = rho & 15; return 8 * (i >> 2) + 4 * n + (i & 3); }
typedef float f32x2_c __attribute__((ext_vector_type(2))); typedef __bf16 bf16x2_c __attribute__((ext_vector_type(2)));
DEV unsigned cvt_pk_bf16(float lo, float hi) { const f32x2_c v = {lo, hi}; const bf16x2_c b = __builtin_convertvector(v, bf16x2_c); return __builtin_bit_cast(unsigned, b); }
DEV float fsigm(float x) { return __builtin_amdgcn_rcpf(1.f + __builtin_amdgcn_exp2f(-1.4426950408889634f * x)); }

struct Unit { const char* A; const char* B; const int* gidx; int orow, ocol, pm, pn, e; };

struct GridOrder {
    int nM, nN, nwg, G, c;
    DEV void init(int nM_, int nN_, int G_, int c_) { nM = nM_; nN = nN_; nwg = nM * nN; G = G_; c = c_; }
    DEV bool tile(int i, int& pm, int& pn) const {
        const long L = (long)i * G + c; if (L >= nwg) return false;
        int wgid = (int)L; { const int q = nwg / NXCD, r = nwg % NXCD, xcd = wgid % NXCD, off = wgid / NXCD; wgid = (xcd < r ? xcd * (q + 1) : r * (q + 1) + (xcd - r) * q) + off; }
        const int nig = WGM * nN, gid = wgid / nig, fm = gid * WGM, gsz = (nM - fm) < WGM ? (nM - fm) : WGM;
        pm = fm + ((wgid % nig) % gsz); pn = (wgid % nig) / gsz; return true;
    }
};

struct EpiBf16 {
    static constexpr bool PERM = true;
    bf16_t* O; int ldc;
    DEV void operator()(const f32x4 (&acc)[2][2][4][2], const Unit& u, int wr, int wc, int fr, int fq) const {
        const int row0 = u.orow + wr * 64 + fr, col0 = u.ocol + wc * 32 + 8 * fq;
#pragma unroll
        for (int ai = 0; ai < 2; ++ai)
#pragma unroll
            for (int m = 0; m < 4; ++m) { bf16_t* rowp = O + (size_t)(row0 + ai * HALF + m * 16) * ldc + col0;
#pragma unroll
                for (int bj = 0; bj < 2; ++bj) { const f32x4 v0 = acc[ai][bj][m][0], v1 = acc[ai][bj][m][1];
                    u32x4 w; w.x = cvt_pk_bf16(v0[0], v0[1]); w.y = cvt_pk_bf16(v0[2], v0[3]); w.z = cvt_pk_bf16(v1[0], v1[1]); w.w = cvt_pk_bf16(v1[2], v1[3]);
                    *(u32x4*)(rowp + bj * HALF) = w; } }
    }
};

template <class Epi, class Sched, bool ALIGN_EPI, bool GATHER, int K, int lda>
DEV void gemm_phase(LAS unsigned char* lds, const Sched& S, const Epi& E, const unsigned z, const int tid_) {
    const int tid = tid_, wid = __builtin_amdgcn_readfirstlane(tid >> 6), lane = tid & 63, wr = wid >> 2, wc = wid & 3, fr = lane & 15, fq = lane >> 4;
    const int nt = K / BK; const float zf = __uint_as_float(z);
    int Ra[2], Ca[2]; unsigned voffB[2];
#pragma unroll
    for (int i = 0; i < 2; ++i) { int R, C; stage_rc(tid * 16 + i * 8192, R, C); const int Rb = Epi::PERM ? ((R & ~31) + perm32(R & 31)) : R; Ra[i] = R; Ca[i] = C; voffB[i] = (unsigned)(Rb * K + C) * 2u; }
    const size_t kstep = (size_t)(BK * 2);
    const size_t hstepB = (size_t)HALF * K * 2;
    const unsigned ldsw = (unsigned)wid * 1024u;
    const int aoff = lds_byte(wr * 64 + fr, fq * 8), boff = lds_byte(wc * 32 + fr, fq * 8);
#define PG_SA(b, h) (((b) * 2 + (h)) * HTB)
#define PG_SB(b, h) ((4 + (b) * 2 + (h)) * HTB)
#define PG_STAGE_B(bufoff, gbase) do { _Pragma("unroll") for (int _i = 0; _i < 2; ++_i) \
        __builtin_amdgcn_global_load_lds((const unsigned*)((const char*)(gbase) + voffB[_i]), (LAS unsigned*)(lds + (bufoff) + ldsw + _i * 8192), 16, 0, 0); } while (0)
#define PG_STAGE_A(bufoff, gbase, vo) do { _Pragma("unroll") for (int _i = 0; _i < 2; ++_i) \
        __builtin_amdgcn_global_load_lds((const unsigned*)((const char*)(gbase) + (vo)[_i]), (LAS unsigned*)(lds + (bufoff) + ldsw + _i * 8192), 16, 0, 0); } while (0)
#define PG_LDA(dst, b, h) do { _Pragma("unroll") for (int m = 0; m < 4; ++m) _Pragma("unroll") for (int k = 0; k < 2; ++k) dst[m][k] = *(const LAS bf16x8*)(lds + PG_SA(b, h) + aoff + m * 2048 + k * 1024); } while (0)
#define PG_LDB(dst, b, h) do { _Pragma("unroll") for (int n = 0; n < 2; ++n) _Pragma("unroll") for (int k = 0; k < 2; ++k) dst[n][k] = *(const LAS bf16x8*)(lds + PG_SB(b, h) + boff + n * 2048 + k * 1024); } while (0)
#define PG_MMA(ai, bj, At, Bt) do { __builtin_amdgcn_s_setprio(1); _Pragma("unroll") for (int m = 0; m < 4; ++m) _Pragma("unroll") for (int n = 0; n < 2; ++n) _Pragma("unroll") for (int k = 0; k < 2; ++k) \
        acc[ai][bj][m][n] = __builtin_amdgcn_mfma_f32_16x16x32_bf16(Bt[n][k], At[m][k], acc[ai][bj][m][n], 0, 0, 0); __builtin_amdgcn_s_setprio(0); } while (0)
#define PG_WAIT_V(n) asm volatile("s_waitcnt vmcnt(" #n ")" ::: "memory")
#define PG_WAIT_L(n) asm volatile("s_waitcnt lgkmcnt(" #n ")" ::: "memory")
#define PG_BAR __builtin_amdgcn_s_barrier()
#define PG_SCHED __builtin_amdgcn_sched_barrier(0)
#define PG_MKVOFF(u, vo) do { _Pragma("unroll") for (int _h = 0; _h < 2; ++_h) _Pragma("unroll") for (int _i = 0; _i < 2; ++_i) { const int _row = _h * HALF + Ra[_i]; \
        const int _rr = GATHER ? (u).gidx[_row] : _row; (vo)[_h][_i] = (unsigned)(_rr * lda + Ca[_i]) * 2u; } } while (0)
    Unit cur, nxt; int ui = 0;
    if (!S.next(0, cur)) return;
    f32x4 acc[2][2][4][2];
#pragma unroll
    for (int a = 0; a < 2; ++a)
#pragma unroll
        for (int b = 0; b < 2; ++b)
#pragma unroll
            for (int m = 0; m < 4; ++m)
#pragma unroll
                for (int n = 0; n < 2; ++n) acc[a][b][m][n] = (f32x4){zf, zf, zf, zf};
    bf16x8 At[4][2], B0[2][2], B1[2][2];
    unsigned vc[2][2], vn[2][2];
    PG_MKVOFF(cur, vc);
    const char* cA = cur.A; const char* cB = cur.B;
    PG_STAGE_B(PG_SB(0, 0), cB); PG_STAGE_B(PG_SB(0, 1), cB + hstepB); PG_STAGE_A(PG_SA(0, 0), cA, vc[0]); PG_STAGE_A(PG_SA(0, 1), cA, vc[1]);
    if (wr == 1) PG_BAR;
    PG_WAIT_V(2); PG_BAR;
    PG_STAGE_B(PG_SB(1, 0), cB + kstep); PG_STAGE_A(PG_SA(1, 0), cA + kstep, vc[0]); PG_STAGE_B(PG_SB(1, 1), cB + hstepB + kstep);
    PG_WAIT_V(6); PG_BAR;
    for (;;) {
        const bool has_next = S.next(ui + 1, nxt);
        if constexpr (GATHER) { if (has_next) { PG_MKVOFF(nxt, vn); } else {
#pragma unroll
            for (int h = 0; h < 2; ++h)
#pragma unroll
                for (int i = 0; i < 2; ++i) vn[h][i] = vc[h][i]; } }
        const char* nA = has_next ? nxt.A : cA; const char* nB = has_next ? nxt.B : cB;
#pragma unroll 1
        for (int t = 0; t < nt; t += 2) {
            const bool last = (t == nt - 2);
            const char* a1 = cA + (size_t)(t + 1) * kstep;
            const char* a2 = last ? nA : cA + (size_t)(t + 2) * kstep; const char* b2 = last ? nB : cB + (size_t)(t + 2) * kstep;
            const char* a3 = a2 + kstep; const char* b3 = b2 + kstep;
            unsigned v2[2][2];
#pragma unroll
            for (int h = 0; h < 2; ++h)
#pragma unroll
                for (int i = 0; i < 2; ++i) v2[h][i] = (GATHER && last) ? vn[h][i] : vc[h][i];
            PG_LDB(B0, 0, 0); PG_LDB(B1, 0, 1); PG_SCHED; PG_LDA(At, 0, 0); PG_STAGE_A(PG_SA(1, 1), a1, vc[1]);
            PG_WAIT_V(8); PG_WAIT_L(0); PG_BAR; PG_MMA(0, 0, At, B0); PG_MMA(0, 1, At, B1); PG_BAR; PG_SCHED;
            PG_LDA(At, 0, 1); PG_STAGE_B(PG_SB(0, 0), b2); PG_STAGE_B(PG_SB(0, 1), b2 + hstepB); PG_STAGE_A(PG_SA(0, 0), a2, v2[0]);
            PG_WAIT_V(8); PG_WAIT_L(0); PG_BAR; PG_MMA(1, 0, At, B0); PG_MMA(1, 1, At, B1); PG_BAR; PG_SCHED;
            PG_LDB(B0, 1, 0); PG_LDB(B1, 1, 1); PG_SCHED; PG_LDA(At, 1, 0); PG_STAGE_A(PG_SA(0, 1), a2, v2[1]);
            PG_WAIT_V(8); PG_WAIT_L(0); PG_BAR; PG_MMA(0, 0, At, B0); PG_MMA(0, 1, At, B1); PG_BAR; PG_SCHED;
            PG_LDA(At, 1, 1); PG_STAGE_B(PG_SB(1, 0), b3); PG_STAGE_B(PG_SB(1, 1), b3 + hstepB); PG_STAGE_A(PG_SA(1, 0), a3, v2[0]);
            PG_WAIT_V(8); PG_WAIT_L(0); PG_BAR; PG_MMA(1, 0, At, B0); PG_MMA(1, 1, At, B1); PG_BAR; PG_SCHED;
        }
        if constexpr (ALIGN_EPI) { if (wr == 0) PG_BAR; }
        E(acc, cur, wr, wc, fr, fq);
        if (!has_next) break;
#pragma unroll
        for (int a = 0; a < 2; ++a)
#pragma unroll
            for (int b = 0; b < 2; ++b)
#pragma unroll
                for (int m = 0; m < 4; ++m)
#pragma unroll
                    for (int n = 0; n < 2; ++n) acc[a][b][m][n] = (f32x4){zf, zf, zf, zf};
        cur = nxt; cA = nA; cB = nB; ++ui;
        if constexpr (GATHER) {
#pragma unroll
        for (int h = 0; h < 2; ++h)
#pragma unroll
            for (int i = 0; i < 2; ++i) vc[h][i] = vn[h][i]; }
        if constexpr (ALIGN_EPI) { if (wr == 1) PG_BAR; }
    }
    PG_WAIT_V(0);
    if constexpr (!ALIGN_EPI) { if (wr == 0) PG_BAR; }
    PG_BAR;
}
}

constexpr size_t WS_W = 389 * MiB;
constexpr size_t WO_WIN = 0, WO_WM = WO_WIN + (size_t)ZW * 1024 * 2, WO_WB = WO_WM + (size_t)4096 * 1024 * 2, WO_WO = WO_WB + (size_t)4096 * 256 * 2,
                 WO_WGU = WO_WO + (size_t)1024 * 1024 * 2, WO_WD = WO_WGU + (size_t)NE * 2048 * 1024 * 2, WO_END = WO_WD + (size_t)NE * 1024 * 1024 * 2;
static_assert(WS_W + WO_END <= 505 * MiB, "weight region");
DEV void cvt_locate(const PV& p, const int l, int r, const int lane, const float*& src, size_t& ld, bf16_t*& dst, int& K) {
    constexpr int I_A = (ZW / 32) * 16, I_B = 128 * 16, I_C = 128 * 4, I_D = 32 * 16, I_E = NE * 64 * 16;
    unsigned char* W = p.wsb() + WS_W; const int c4 = 4 * (lane & 7), kr = lane >> 3;
    if (r < I_A) { const int nb_ = r / 16, k0 = (r % 16) * 64, n = nb_ * 32 + c4, oc = n < 3584 ? n : n + 16;
        src = p.inp(I_WIN) + (size_t)l * 1024 * DIN + (size_t)(k0 + kr) * DIN + oc; ld = DIN; dst = (bf16_t*)(W + WO_WIN) + (size_t)(nb_ * 32) * 1024 + k0; K = 1024; return; } r -= I_A;
    if (r < I_B) { const int nb_ = r / 16, k0 = (r % 16) * 64, c0 = nb_ * 32, pn = c0 >> 8, bj = (c0 >> 7) & 1, wc = (c0 >> 5) & 3, n_ = c4 >> 4, x = c4 & 15, n4 = 2 * bj + n_, j = 64 * pn + 16 * wc + x;
        src = p.inp(I_WMG) + ((size_t)l * 4 + n4) * 1024 * 1024 + (size_t)(k0 + kr) * 1024 + j; ld = 1024; dst = (bf16_t*)(W + WO_WM) + (size_t)c0 * 1024 + k0; K = 1024; return; } r -= I_B;
    if (r < I_C) { const int nb_ = r / 4, k0 = (r % 4) * 64, c0 = nb_ * 32, n4 = c0 >> 10, j = (c0 & 1023) + c4;
        src = p.inp(I_WBR) + ((size_t)l * 4 + n4) * 256 * 1024 + (size_t)(k0 + kr) * 1024 + j; ld = 1024; dst = (bf16_t*)(W + WO_WB) + (size_t)c0 * 256 + k0; K = 256; return; } r -= I_C;
    if (r < I_D) { const int nb_ = r / 16, k0 = (r % 16) * 64;
        src = p.inp(I_WOUT) + (size_t)l * 1024 * 1024 + (size_t)(k0 + kr) * 1024 + nb_ * 32 + c4; ld = 1024; dst = (bf16_t*)(W + WO_WO) + (size_t)(nb_ * 32) * 1024 + k0; K = 1024; return; } r -= I_D;
    if (r < I_E) { const int e = r / (64 * 16), rr = r % (64 * 16), nb_ = rr % 64, k0 = (rr / 64) * 64, c0 = nb_ * 32, pn = c0 >> 8, bj = (c0 >> 7) & 1, cc = (c0 & 127) + c4;
        src = (bj ? p.inp(I_WEU) : p.inp(I_WEG)) + ((size_t)l * NE + e) * 1024 * 1024 + (size_t)(k0 + kr) * 1024 + 128 * pn + cc; ld = 1024;
        dst = (bf16_t*)(W + WO_WGU) + ((size_t)e * 2048 + c0) * 1024 + k0; K = 1024; return; } r -= I_E;
    { const int e = r / (32 * 16), rr = r % (32 * 16), nb_ = rr % 32, k0 = (rr / 32) * 64;
        src = p.inp(I_WED) + ((size_t)l * NE + e) * 1024 * 1024 + (size_t)(k0 + kr) * 1024 + nb_ * 32 + c4; ld = 1024; dst = (bf16_t*)(W + WO_WD) + ((size_t)e * 1024 + nb_ * 32) * 1024 + k0; K = 1024; }
}
DEV void cvt_store(const f32x4 (&v)[8], bf16_t* dst, const int K, LAS float* scr, const int lane) {
    { const int kr = lane >> 3, x = lane & 7, sh = 8 * ((x >> 2) & 1);
#pragma unroll
      for (int i = 0; i < 8; ++i)
#pragma unroll
        for (int e = 0; e < 4; ++e) scr[(4 * x + e) * 68 + ((8 * i + kr + sh) & 63)] = v[i][e]; }
    const int c = lane & 7;
#pragma unroll
    for (int j = 0; j < 4; ++j) { const int n = (lane >> 3) + 8 * j; const LAS float* s = scr + n * 68 + ((8 * c + 8 * ((n >> 4) & 1)) & 63);
        const f32x4 lo = *(const LAS f32x4*)s, hi = *(const LAS f32x4*)(s + 4);
        pg::u32x4 o; o.x = pg::cvt_pk_bf16(lo.x, lo.y); o.y = pg::cvt_pk_bf16(lo.z, lo.w); o.z = pg::cvt_pk_bf16(hi.x, hi.y); o.w = pg::cvt_pk_bf16(hi.z, hi.w);
        *(pg::u32x4*)(dst + (size_t)n * K + 8 * c) = o; }
}
DEV void ph_wconv(const PV& p, const int l, int bid, int nb, LAS unsigned char* lds3, const int part  ) {
    const int lane = TIDX & 63, wave = p.wv;
    LAS float* scr = (LAS float*)(lds3 + wave * 8704);
    constexpr int I_A = (ZW / 32) * 16, I_B = 128 * 16, I_C = 128 * 4, I_D = 32 * 16, I_E = NE * 64 * 16, I_F = NE * 32 * 16;
    constexpr int NITEMS = I_A + I_B + I_C + I_D + I_E + I_F;
    const int it0 = part ? I_A + I_B + I_C + I_D : 0, it1 = part ? NITEMS : I_A + I_B + I_C + I_D;
    const int skip = part ? (l == 0 ? 2 * NE : NE) : 0;
    if (bid < skip) return;
    const int step = (nb - skip) * 8;
    int it = it0 + (bid - skip) * 8 + wave;
    const float* src; size_t ld; bf16_t* dst; int K; f32x4 vn[8];
    if (it < it1) { cvt_locate(p, l, it, lane, src, ld, dst, K);
#pragma unroll
        for (int i = 0; i < 8; ++i) vn[i] = *(const f32x4*)(src + (size_t)(8 * i) * ld); }
    while (it < it1) {
        f32x4 v[8]; bf16_t* dc = dst; const int Kc = K;
#pragma unroll
        for (int i = 0; i < 8; ++i) v[i] = vn[i];
        it += step;
        if (it < it1) { cvt_locate(p, l, it, lane, src, ld, dst, K);
#pragma unroll
            for (int i = 0; i < 8; ++i) vn[i] = *(const f32x4*)(src + (size_t)(8 * i) * ld); }
        cvt_store(v, dc, Kc, scr, lane);
    }
}

struct SchedG1 { pg::GridOrder o; const char* A; const char* B;
    DEV bool next(int i, pg::Unit& u) const { int pm, pn; if (!o.tile(i, pm, pn)) return false;
        u.A = A + (size_t)pm * 256 * 1024 * 2; u.B = B + (size_t)pn * 256 * 1024 * 2; u.gidx = nullptr; u.orow = pm * 256; u.ocol = pn * 256; u.pm = pm; u.pn = pn; u.e = 0; return true; } };
DEV void ph_g1_fast(const PV& p, int bid, int nb, LAS unsigned char* lds3) {
    SchedG1 S; S.o.init(T / 256, ZW / 256, nb, bid); S.A = (const char*)(p.wsb() + WS_H); S.B = (const char*)(p.wsb() + WS_W + WO_WIN);
    pg::EpiBf16 E{wsp<bf16_t>(p, WS_Z), ZW};
    pg::gemm_phase<pg::EpiBf16, SchedG1, true, false, 1024, 1024>(lds3, S, E, p.z, p.tid());
}

namespace pg {
struct EpiF32 {
    static constexpr bool PERM = false;
    float* O; int ldc;
    DEV void operator()(const f32x4 (&acc)[2][2][4][2], const Unit& u, int wr, int wc, int fr, int fq) const {
        const int row0 = u.orow + wr * 64 + fr, col0 = u.ocol + wc * 32 + 4 * fq;
#pragma unroll
        for (int ai = 0; ai < 2; ++ai)
#pragma unroll
            for (int m = 0; m < 4; ++m) { float* rowp = O + (size_t)(row0 + ai * HALF + m * 16) * ldc + col0;
#pragma unroll
                for (int bj = 0; bj < 2; ++bj)
#pragma unroll
                    for (int n = 0; n < 2; ++n) *(f32x4*)(rowp + bj * HALF + n * 16) = acc[ai][bj][m][n]; }
    }
};
struct EpiMerge {
    static constexpr bool PERM = false;
    const bf16_t* Bb; bf16_t* Mo;
    DEV void operator()(const f32x4 (&acc)[2][2][4][2], const Unit& u, int wr, int wc, int fr, int fq) const {
        const int row0 = u.orow + wr * 64 + fr, jb = u.pn * 64 + 16 * wc + 4 * fq;
#pragma unroll
        for (int ai = 0; ai < 2; ++ai)
#pragma unroll
            for (int m = 0; m < 4; ++m) { const int row = row0 + ai * HALF + m * 16; const bf16_t* bp = Bb + (size_t)row * 4096 + jb;
                f32x4 s = (f32x4){0.f, 0.f, 0.f, 0.f};
#pragma unroll
                for (int bj = 0; bj < 2; ++bj)
#pragma unroll
                    for (int n = 0; n < 2; ++n) { const u32x2 w = *(const u32x2*)(bp + (2 * bj + n) * 1024); const f32x4 a = acc[ai][bj][m][n];
                        s[0] += fsigm(a[0]) * __uint_as_float(w.x << 16); s[1] += fsigm(a[1]) * __uint_as_float(w.x & 0xffff0000u);
                        s[2] += fsigm(a[2]) * __uint_as_float(w.y << 16); s[3] += fsigm(a[3]) * __uint_as_float(w.y & 0xffff0000u); }
                u32x2 o; o.x = cvt_pk_bf16(s[0], s[1]); o.y = cvt_pk_bf16(s[2], s[3]);
                *(u32x2*)(Mo + (size_t)row * 1024 + jb) = o; }
    }
};
struct EpiAct {
    static constexpr bool PERM = true;
    bf16_t* O;
    DEV void operator()(const f32x4 (&acc)[2][2][4][2], const Unit& u, int wr, int wc, int fr, int fq) const {
        const int row0 = u.orow + wr * 64 + fr, col0 = u.ocol + wc * 32 + 8 * fq;
#pragma unroll
        for (int ai = 0; ai < 2; ++ai)
#pragma unroll
            for (int m = 0; m < 4; ++m) { const f32x4 g0 = acc[ai][0][m][0], g1 = acc[ai][0][m][1], u0 = acc[ai][1][m][0], u1 = acc[ai][1][m][1];
                float a[8];
#pragma unroll
                for (int e = 0; e < 4; ++e) { a[e] = g0[e] * fsigm(g0[e]) * u0[e]; a[4 + e] = g1[e] * fsigm(g1[e]) * u1[e]; }
                u32x4 w; w.x = cvt_pk_bf16(a[0], a[1]); w.y = cvt_pk_bf16(a[2], a[3]); w.z = cvt_pk_bf16(a[4], a[5]); w.w = cvt_pk_bf16(a[6], a[7]);
                *(u32x4*)(O + (size_t)(row0 + ai * HALF + m * 16) * 1024 + col0) = w; }
    }
};
}
struct SchedDense { pg::GridOrder o; const char* A; const char* B; int pm0, lda, K, acol_shift  ;
    DEV bool next(int i, pg::Unit& u) const { int pm, pn; if (!o.tile(i, pm, pn)) return false; pm += pm0;
        u.A = A + ((size_t)pm * 256 * lda + (acol_shift >= 0 ? (size_t)(pn >> acol_shift) * K : 0)) * 2; u.B = B + (size_t)pn * 256 * K * 2;
        u.gidx = nullptr; u.orow = pm * 256; u.ocol = pn * 256; u.pm = pm; u.pn = pn; u.e = 0; return true; } };
struct SchedExp { pg::GridOrder o; const char* A; const char* B; const int* idx; int RT, ntn, ocol_w; bool gather;
    DEV bool next(int i, pg::Unit& u) const { int pm, pn; if (!o.tile(i, pm, pn)) return false; const int e = pm / RT, rt = pm % RT, row = e * EROWS + rt * 256;
        u.A = gather ? A : A + (size_t)row * 1024 * 2; u.gidx = idx + row; u.B = B + ((size_t)e * ntn + pn) * 256 * 1024 * 2;
        u.orow = row; u.ocol = pn * ocol_w; u.pm = pm; u.pn = pn; u.e = e; return true; } };

DEV void ph_g2_fast(const PV& p, const int l, int bid, int nb, LAS unsigned char* lds3) {
    SchedDense S; S.o.init(T / 256 - l, 16, nb, bid); S.A = (const char*)(p.wsb() + WS_Y); S.B = (const char*)(p.wsb() + WS_W + WO_WB); S.pm0 = l; S.lda = 1024; S.K = 256; S.acol_shift = 2;
    pg::EpiBf16 E{wsp<bf16_t>(p, WS_Z), 4096};
    pg::gemm_phase<pg::EpiBf16, SchedDense, true, false, 256, 1024>(lds3, S, E, p.z, p.tid());
}
struct SchedOne { const char* A; const char* B; int pm, pn, lda, K;
    DEV bool next(int i, pg::Unit& u) const { if (i > 0) return false;
        u.A = A + (size_t)pm * 256 * lda * 2; u.B = B + (size_t)pn * 256 * K * 2; u.gidx = nullptr; u.orow = pm * 256; u.ocol = pn * 256; u.pm = pm; u.pn = pn; u.e = 0; return true; } };
constexpr int XD_CTXCNT = 8192;
DEV void ph_g3_fast(const PV& p, const int l, int bid, int nb, LAS unsigned char* lds3) {
    pg::EpiMerge E{wsp<bf16_t>(p, WS_Z), wsp<bf16_t>(p, WS_M)};
    unsigned* cnt = (unsigned*)p.wsb() + XD_CTXCNT;
    const bool oob = (l == 0) && nb >= 20;
    if (oob && bid < 16) {
        SchedOne S1{(const char*)(p.wsb() + WS_H), (const char*)(p.wsb() + WS_W + WO_WM), 0, bid, 1024, 1024};
        pg::gemm_phase<pg::EpiMerge, SchedOne, true, false, 1024, 1024>(lds3, S1, E, p.z, p.tid());
        asm volatile("s_waitcnt vmcnt(0)" ::: "memory");
        __syncthreads();
        if (p.tid() == 0) { __builtin_amdgcn_fence(__ATOMIC_RELEASE, "agent"); asm volatile("s_waitcnt vmcnt(0)" ::: "memory");
            (void)__hip_atomic_fetch_add(cnt, 1u, __ATOMIC_RELAXED, __HIP_MEMORY_SCOPE_AGENT); }
    }
    {   SchedDense S; S.o.init(oob ? 64 : T / 256 - l, 16, nb, bid); S.A = (const char*)(p.wsb() + WS_H); S.B = (const char*)(p.wsb() + WS_W + WO_WM); S.pm0 = oob ? 1 : l; S.lda = 1024; S.K = 1024; S.acol_shift = -1;
        pg::gemm_phase<pg::EpiMerge, SchedDense, true, false, 1024, 1024>(lds3, S, E, p.z, p.tid()); }
    if (oob && bid >= 16 && bid < 20) {
        if (p.tid() == 0) { unsigned sp = 0; while (__hip_atomic_load(cnt, __ATOMIC_RELAXED, __HIP_MEMORY_SCOPE_AGENT) < 16u) { __builtin_amdgcn_s_sleep(2); if (++sp > (1u << 22)) break; } }
        __syncthreads();
        __builtin_amdgcn_fence(__ATOMIC_ACQUIRE, "agent");
        asm volatile("s_waitcnt vmcnt(0)" ::: "memory");
        SchedOne S1{(const char*)(p.wsb() + WS_M), (const char*)(p.wsb() + WS_W + WO_WO), 0, bid - 16, 1024, 1024};
        pg::EpiF32 E4{wsp<float>(p, WS_YO), 1024};
        pg::gemm_phase<pg::EpiF32, SchedOne, true, false, 1024, 1024>(lds3, S1, E4, p.z, p.tid());
    }
}
DEV void ph_g4_fast(const PV& p, const int l, int bid, int nb, LAS unsigned char* lds3) {
    const bool oob = (l == 0) && nb >= 20;
    SchedDense S; S.o.init(oob ? 64 : T / 256 - l, 4, nb, bid); S.A = (const char*)(p.wsb() + WS_M); S.B = (const char*)(p.wsb() + WS_W + WO_WO); S.pm0 = oob ? 1 : l; S.lda = 1024; S.K = 1024; S.acol_shift = -1;
    pg::EpiF32 E{wsp<float>(p, WS_YO), 1024};
    pg::gemm_phase<pg::EpiF32, SchedDense, true, false, 1024, 1024>(lds3, S, E, p.z, p.tid());
}
DEV void ph_g5_fast(const PV& p, const int l, int bid, int nb, LAS unsigned char* lds3) {
    SchedExp S; S.RT = l ? 8 : 9; S.o.init(NE * S.RT, 8, nb, bid); S.A = (const char*)(p.wsb() + WS_H); S.B = (const char*)(p.wsb() + WS_W + WO_WGU); S.idx = wsp<int>(p, WS_IDX); S.ntn = 8; S.ocol_w = 128; S.gather = true;
    pg::EpiAct E{wsp<bf16_t>(p, WS_ACT)};
    pg::gemm_phase<pg::EpiAct, SchedExp, true, true, 1024, 1024>(lds3, S, E, p.z, p.tid());
}
DEV void ph_g6_fast(const PV& p, const int l, int bid, int nb, LAS unsigned char* lds3) {
    SchedExp S; S.RT = l ? 8 : 9; S.o.init(NE * S.RT, 4, nb, bid); S.A = (const char*)(p.wsb() + WS_ACT); S.B = (const char*)(p.wsb() + WS_W + WO_WD); S.idx = wsp<int>(p, WS_IDX); S.ntn = 4; S.ocol_w = 256; S.gather = false;
    pg::EpiBf16 E{wsp<bf16_t>(p, WS_YE), 1024};
    pg::gemm_phase<pg::EpiBf16, SchedExp, true, false, 1024, 1024>(lds3, S, E, p.z, p.tid());
}

#define ATTN_STORE16(p,v) (*(u32x4*)(p)=(v))
namespace attn_body {
using bf16=unsigned short;
using bf16x8=__attribute__((ext_vector_type(8)))short;
using s16x4=__attribute__((ext_vector_type(4)))short;
using f32x16=__attribute__((ext_vector_type(16)))float;
using u32x4=__attribute__((ext_vector_type(4)))unsigned;
constexpr int D=64,QP=256,KP=128,OP=1024;
constexpr int NW=8,QBLK=32,QB=QBLK*NW,KVBLK=64;
__device__ __forceinline__ int crow(int r,int hi){return (r&3)+8*(r>>2)+4*hi;}
#define SBAR() __builtin_amdgcn_sched_barrier(0)
constexpr int NSLOT=3, SLOTB=8192;
constexpr int LDS_K=0, LDS_V=NSLOT*SLOTB, LDS_WS=2*NSLOT*SLOTB, LDS_OST=LDS_WS+NW*64*4, LDS_BYTES=LDS_OST+NW*4096;
constexpr float C2=0.125f*1.4426950408889634f;
__device__ __forceinline__ void glds16(const void*gsrc,unsigned lds_dst){unsigned keep;
  asm volatile("s_mov_b32 %0, m0\n\ts_mov_b32 m0, %2\n\ts_nop 0\n\tglobal_load_lds_dwordx4 %1, off\n\ts_mov_b32 m0, %0":"=&s"(keep):"v"(gsrc),"s"(lds_dst):"memory");}
__device__ __forceinline__ float max3f(float a,float b,float c){float r;asm("v_max3_f32 %0, %1, %2, %3":"=v"(r):"v"(a),"v"(b),"v"(c));return r;}
__device__ __forceinline__ float max2f(float a,float b){float r;asm("v_max_f32_e32 %0, %1, %2":"=v"(r):"v"(a),"v"(b));return r;}
__device__ __forceinline__ float fadd_s(float a,float b){float r;asm("v_add_f32_e32 %0, %1, %2":"=v"(r):"v"(a),"v"(b));return r;}
__device__ __forceinline__ float fsub_s(float a,float b){float r;asm("v_sub_f32_e32 %0, %1, %2":"=v"(r):"v"(a),"v"(b));return r;}
typedef float f32x2_t __attribute__((ext_vector_type(2))); typedef __bf16 bf16x2_t __attribute__((ext_vector_type(2)));
__device__ __forceinline__ unsigned cvtpk_s(float lo,float hi){f32x2_t v={lo,hi};bf16x2_t b=__builtin_convertvector(v,bf16x2_t);return __builtin_bit_cast(unsigned,b);}
#define WAIT_BAR(N) asm volatile("s_waitcnt vmcnt(" #N ") lgkmcnt(0)\n\ts_barrier":::"memory")

__device__ __forceinline__ void qkt(f32x16&p0,f32x16&p1,const char*Kslot,const bf16x8*qr,const f32x16&negm,int r32,int hi){
  const char*kb=Kslot+hi*1024+r32*16;
  #pragma unroll
  for(int d0=0;d0<4;++d0){
    const bf16x8 b0=*reinterpret_cast<const bf16x8*>(kb+d0*2048);
    const bf16x8 b1=*reinterpret_cast<const bf16x8*>(kb+d0*2048+512);
    if(d0==0){p0=__builtin_amdgcn_mfma_f32_32x32x16_bf16(b0,qr[0],negm,0,0,0);p1=__builtin_amdgcn_mfma_f32_32x32x16_bf16(b1,qr[0],negm,0,0,0);}
    else{p0=__builtin_amdgcn_mfma_f32_32x32x16_bf16(b0,qr[d0],p0,0,0,0);p1=__builtin_amdgcn_mfma_f32_32x32x16_bf16(b1,qr[d0],p1,0,0,0);}}
}
typedef __attribute__((address_space(3))) const char* lds_cptr;
typedef short v4i16_t __attribute__((ext_vector_type(4)));
__device__ __forceinline__ void kload8(bf16x8*kf,lds_cptr kp){
  kf[0]=*(const __attribute__((address_space(3))) bf16x8*)(kp);      kf[1]=*(const __attribute__((address_space(3))) bf16x8*)(kp+512);
  kf[2]=*(const __attribute__((address_space(3))) bf16x8*)(kp+2048); kf[3]=*(const __attribute__((address_space(3))) bf16x8*)(kp+2560);
  kf[4]=*(const __attribute__((address_space(3))) bf16x8*)(kp+4096); kf[5]=*(const __attribute__((address_space(3))) bf16x8*)(kp+4608);
  kf[6]=*(const __attribute__((address_space(3))) bf16x8*)(kp+6144); kf[7]=*(const __attribute__((address_space(3))) bf16x8*)(kp+6656);
}
__device__ __forceinline__ void kload2(bf16x8*kf,lds_cptr kp,int j){ kf[2*j]=*(const __attribute__((address_space(3))) bf16x8*)(kp+j*2048); kf[2*j+1]=*(const __attribute__((address_space(3))) bf16x8*)(kp+j*2048+512); }
__device__ __forceinline__ s16x4 vtr(lds_cptr p){ return __builtin_bit_cast(s16x4,__builtin_amdgcn_ds_read_tr16_b64_v4i16((__attribute__((address_space(3))) v4i16_t*)p)); }
__device__ __forceinline__ float rowmax(const f32x16&p0,const f32x16&p1){
  float a=max3f(p0[0],p0[1],p1[0]),b=max3f(p0[2],p0[3],p1[1]);a=max3f(a,p1[2],p1[3]);
  #pragma unroll
  for(int r=4;r<16;r+=4){a=max3f(a,p0[r],p0[r+1]);b=max3f(b,p0[r+2],p0[r+3]);a=max3f(a,p1[r],p1[r+1]);b=max3f(b,p1[r+2],p1[r+3]);}
  const float m=max2f(a,b);
  auto rr=__builtin_amdgcn_permlane32_swap(__float_as_uint(m),__float_as_uint(m),false,false);
  return max2f(__uint_as_float(rr[0]),__uint_as_float(rr[1]));
}
__device__ __forceinline__ void pv(f32x16*o,int vb,bf16x8 pa0,bf16x8 pa1,bf16x8 pa2,bf16x8 pa3){
  #pragma unroll
  for(int d0=0;d0<2;++d0){s16x4 lo[4],hi[4];
    #pragma unroll
    for(int ks=0;ks<4;++ks){
      asm volatile("ds_read_b64_tr_b16 %0,%1 offset:%c2":"=&v"(lo[ks]):"v"(vb),"i"(d0*4096+ks*1024):"memory");
      asm volatile("ds_read_b64_tr_b16 %0,%1 offset:%c2":"=&v"(hi[ks]):"v"(vb),"i"(d0*4096+ks*1024+512):"memory");}
    asm volatile("s_waitcnt lgkmcnt(0)":::"memory");SBAR();
    #define PK(k) (bf16x8){lo[k][0],lo[k][1],lo[k][2],lo[k][3],hi[k][0],hi[k][1],hi[k][2],hi[k][3]}
    o[d0]=__builtin_amdgcn_mfma_f32_32x32x16_bf16(pa0,PK(0),o[d0],0,0,0);
    o[d0]=__builtin_amdgcn_mfma_f32_32x32x16_bf16(pa1,PK(1),o[d0],0,0,0);
    o[d0]=__builtin_amdgcn_mfma_f32_32x32x16_bf16(pa2,PK(2),o[d0],0,0,0);
    o[d0]=__builtin_amdgcn_mfma_f32_32x32x16_bf16(pa3,PK(3),o[d0],0,0,0);
    #undef PK
  }
}

#ifndef ATTN_STORE16
#define ATTN_STORE16(p,v) (*(u32x4*)(p)=(v))
#endif
template<int THRL,bool NOMAX=false> __device__ __forceinline__ void attn_unit(const int hq,const int row0,const int NT,const bf16*Q,const bf16*__restrict__ K,const bf16*__restrict__ V,bf16*O,char*shm,const unsigned z,const int tid_){
  const int tid=tid_,lane=tid&63,r32=lane&31,hi=lane>>5; const int wid=__builtin_amdgcn_readfirstlane(tid>>6);
  const bf16*Qw=Q+(long)(row0+wid*QBLK)*QP+hq*D;
  const bf16*Kh=K+(hq>>1)*D,*Vh=V+(hq>>1)*D;
  const unsigned lds0=(unsigned)(uintptr_t)shm;
  float*wsf=(float*)(shm+LDS_WS)+wid*64;
  const bf16*ksrc=Kh+(long)lane*KP+wid*8;
  const bf16*vsrc=Vh+(long)(16*(wid&3)+(lane>>2))*KP+(wid>>2)*32+(lane&3)*8;
  const unsigned kdst=lds0+LDS_K+wid*1024, vdst=lds0+LDS_V+wid*1024;
  #define DMA_K(t,slot) glds16(ksrc+(long)(t)*KVBLK*KP,(unsigned)__builtin_amdgcn_readfirstlane(kdst+(slot)))
  #define DMA_V(t,slot) glds16(vsrc+(long)(t)*KVBLK*KP,(unsigned)__builtin_amdgcn_readfirstlane(vdst+(slot)))
  const int vb0=(int)(lds0+LDS_V)+((lane>>4)&1)*32+(lane&3)*8+(4*hi+((lane&15)>>2))*64;
  const char*Kbase=shm+LDS_K; bf16x8 kf[8];
  const lds_cptr shm3=(lds_cptr)shm; const lds_cptr kp0=shm3+LDS_K+hi*1024+r32*16; const lds_cptr vp0=shm3+LDS_V+((lane>>4)&1)*32+(lane&3)*8+(4*hi+((lane&15)>>2))*64;
  DMA_K(0,0);DMA_V(0,0);DMA_K(1,SLOTB);
  bf16x8 qr[4];
  #pragma unroll
  for(int d0=0;d0<4;++d0)qr[d0]=*reinterpret_cast<const bf16x8*>(&Qw[(long)r32*QP+d0*16+hi*8]);
  const float zf_=__uint_as_float(z); float mhat=zf_,l_reg=zf_;f32x16 o[2],negm;
  _Pragma("unroll") for(int r_=0;r_<16;++r_){o[0][r_]=zf_;o[1][r_]=zf_;negm[r_]=zf_;} asm volatile("":"+v"(negm));
  #define CMASK(P0,P1,t) do{}while(0)
  bool resc=false;
  #define START(P0,P1) do{ resc=false; \
    if constexpr(!NOMAX){ const float rm=rowmax(P0,P1); const float dl=rm; mhat=fadd_s(mhat,dl); \
      _Pragma("unroll") for(int r=0;r<16;++r){P0[r]=fsub_s(P0[r],dl);P1[r]=fsub_s(P1[r],dl);} \
      _Pragma("unroll") for(int r=0;r<16;++r)negm[r]=-mhat; asm volatile("":"+v"(negm)); } \
    _Pragma("unroll") for(int r=0;r<16;++r)P0[r]=__builtin_amdgcn_exp2f(P0[r]); }while(0)
  #define RESC() do{ if(resc){ asm volatile("s_waitcnt lgkmcnt(0)":::"memory"); \
      _Pragma("unroll") for(int d_=0;d_<2;++d_) _Pragma("unroll") for(int r=0;r<16;++r)o[d_][r]*=wsf[crow(r,hi)]; } }while(0)
  f32x16 pA0,pA1,pB0,pB1;
  int sl_prev=0,sl_cur=0,sl_next=SLOTB;
  #define ROT() do{sl_prev=sl_cur;sl_cur=sl_next;sl_next=(sl_next==(NSLOT-1)*SLOTB)?0:sl_next+SLOTB;}while(0)
  DMA_K(2,2*SLOTB);
  WAIT_BAR(3);
  qkt(pA0,pA1,Kbase,qr,negm,r32,hi);asm volatile("s_nop 15\n\ts_nop 7":"+v"(pA0),"+v"(pA1));CMASK(pA0,pA1,0);
  START(pA0,pA1);
  _Pragma("unroll") for(int r=0;r<16;++r)pA1[r]=__builtin_amdgcn_exp2f(pA1[r]);
  WAIT_BAR(0);
  DMA_K(3,0);DMA_V(1,SLOTB);
  ROT();
  kload8(kf,kp0+sl_cur);
  WAIT_BAR(2);
  s16x4 vlo[8],vhi[8]; u32x4 pw0,pw1,pw2,pw3;
  #define PKW(P,B) cvtpk_s(P[B],P[B+1])
  #define PAF(k) __builtin_bit_cast(bf16x8,pw##k)
  #define VFR(i) (bf16x8){vlo[i][0],vlo[i][1],vlo[i][2],vlo[i][3],vhi[i][0],vhi[i][1],vhi[i][2],vhi[i][3]}
  #define PIN(x) asm volatile("":"+v"(x))
  #define MX3(a,b,c) __builtin_fmaxf(__builtin_fmaxf((a),(b)),(c))
  #define GAPA(MF,A0,A1,A2,A3,W0,W1,PW) do{ MF; sacc+=A0; sacc+=A1; sacc+=A2; sacc+=A3; PIN(sacc); W0; W1; PIN(PW); SBAR(); }while(0)
  #define EX(v) __builtin_amdgcn_exp2f(v)
  #define GAPB(MF,X,B) do{ MF; X[B]=EX(X[B]); X[B+1]=EX(X[B+1]); X[B+2]=EX(X[B+2]); X[B+3]=EX(X[B+3]); PIN(X); SBAR(); }while(0)
  #define VRD(i) do{ vlo[i]=vtr(vp_+(((i)>>2)*4096+((i)&3)*1024)); vhi[i]=vtr(vp_+(((i)>>2)*4096+((i)&3)*1024+512)); }while(0)
  #define KRD(G,j) do{ if(G){ kload2(kf,kp0+sl_next,j); SBAR(); } }while(0)
  #define STEP(C0,C1,P0,P1,t,GK,GV,GL) do{ SBAR(); \
    const lds_cptr vp_=vp0+sl_prev; \
    VRD(0); SBAR(); float sacc=(P0[0]+P0[1]); \
    GAPA(C0=__builtin_amdgcn_mfma_f32_32x32x16_bf16(kf[0],qr[0],negm,0,0,0), P0[2],P0[3],P0[4],P0[5],     pw0[0]=PKW(P0,0), pw0[1]=PKW(P0,2), pw0); \
    VRD(4); SBAR(); GAPA(C1=__builtin_amdgcn_mfma_f32_32x32x16_bf16(kf[1],qr[0],negm,0,0,0), P0[6],P0[7],P0[8],P0[9],     pw0[2]=PKW(P0,4), pw0[3]=PKW(P0,6), pw0); \
    VRD(1); SBAR(); GAPA(C0=__builtin_amdgcn_mfma_f32_32x32x16_bf16(kf[2],qr[1],C0,0,0,0),   P0[10],P0[11],P0[12],P0[13], pw1[0]=PKW(P0,8), pw1[1]=PKW(P0,10), pw1); \
    VRD(5); SBAR(); GAPA(C1=__builtin_amdgcn_mfma_f32_32x32x16_bf16(kf[3],qr[1],C1,0,0,0),   P0[14],P0[15],P1[0],P1[1],   pw1[2]=PKW(P0,12),pw1[3]=PKW(P0,14), pw1); \
    VRD(2); SBAR(); GAPA(C0=__builtin_amdgcn_mfma_f32_32x32x16_bf16(kf[4],qr[2],C0,0,0,0),   P1[2],P1[3],P1[4],P1[5],     pw2[0]=PKW(P1,0), pw2[1]=PKW(P1,2), pw2); \
    VRD(6); SBAR(); GAPA(C1=__builtin_amdgcn_mfma_f32_32x32x16_bf16(kf[5],qr[2],C1,0,0,0),   P1[6],P1[7],P1[8],P1[9],     pw2[2]=PKW(P1,4), pw2[3]=PKW(P1,6), pw2); \
    VRD(3); SBAR(); GAPA(C0=__builtin_amdgcn_mfma_f32_32x32x16_bf16(kf[6],qr[3],C0,0,0,0),   P1[10],P1[11],P1[12],P1[13], pw3[0]=PKW(P1,8), pw3[1]=PKW(P1,10), pw3); \
    VRD(7); SBAR(); GAPA(C1=__builtin_amdgcn_mfma_f32_32x32x16_bf16(kf[7],qr[3],C1,0,0,0),   P1[14],P1[15],0.f,0.f,       pw3[2]=PKW(P1,12),pw3[3]=PKW(P1,14), pw3); \
    l_reg+=sacc; \
    if(GK){DMA_K((t)+3,sl_cur);} if(GV){DMA_V((t)+1,sl_next);} \
    CMASK(C0,C1,t); \
    if constexpr(!NOMAX){ float a=MX3(C0[0],C0[1],C1[0]),b=MX3(C0[2],C0[3],C1[1]); a=MX3(a,C1[2],C1[3]); \
      _Pragma("unroll") for(int r=4;r<16;r+=4){a=MX3(a,C0[r],C0[r+1]);b=MX3(b,C0[r+2],C0[r+3]);a=MX3(a,C1[r],C1[r+1]);b=MX3(b,C1[r+2],C1[r+3]);} \
      float rm=__builtin_fmaxf(a,b); { auto rr=__builtin_amdgcn_permlane32_swap(__float_as_uint(rm),__float_as_uint(rm),false,false); rm=__builtin_fmaxf(__uint_as_float(rr[0]),__uint_as_float(rr[1])); } \
      resc=false; \
      if(__builtin_expect(__any(rm>(float)THRL),0)){ const float dl=__builtin_fmaxf(rm,0.f); mhat+=dl; \
        _Pragma("unroll") for(int r=0;r<16;++r){C0[r]-=dl;C1[r]-=dl;} \
        _Pragma("unroll") for(int r=0;r<16;++r)negm[r]=-mhat; asm volatile("":"+v"(negm)); \
        const float f=__builtin_amdgcn_exp2f(-dl); l_reg*=f; if(hi==0)wsf[r32]=f; resc=true; } } \
    SBAR(); \
    GAPB(o[0]=__builtin_amdgcn_mfma_f32_32x32x16_bf16(PAF(0),VFR(0),o[0],0,0,0), C0,0); \
    GAPB(o[1]=__builtin_amdgcn_mfma_f32_32x32x16_bf16(PAF(0),VFR(4),o[1],0,0,0), C0,4); \
    KRD(GL,0); GAPB(o[0]=__builtin_amdgcn_mfma_f32_32x32x16_bf16(PAF(1),VFR(1),o[0],0,0,0), C0,8); \
    KRD(GL,1); GAPB(o[1]=__builtin_amdgcn_mfma_f32_32x32x16_bf16(PAF(1),VFR(5),o[1],0,0,0), C0,12); \
    KRD(GL,2); GAPB(o[0]=__builtin_amdgcn_mfma_f32_32x32x16_bf16(PAF(2),VFR(2),o[0],0,0,0), C1,0); \
    KRD(GL,3); GAPB(o[1]=__builtin_amdgcn_mfma_f32_32x32x16_bf16(PAF(2),VFR(6),o[1],0,0,0), C1,4); \
    GAPB(o[0]=__builtin_amdgcn_mfma_f32_32x32x16_bf16(PAF(3),VFR(3),o[0],0,0,0), C1,8); \
    GAPB(o[1]=__builtin_amdgcn_mfma_f32_32x32x16_bf16(PAF(3),VFR(7),o[1],0,0,0), C1,12); \
    }while(0)
  int t=1;
  #undef CMASK
  #define CMASK(P0,P1,t) do{}while(0)
  for(;t+5<NT;t+=2){
    STEP(pB0,pB1,pA0,pA1,t,true,true,true);     WAIT_BAR(2); RESC(); ROT();
    STEP(pA0,pA1,pB0,pB1,t+1,true,true,true);   WAIT_BAR(2); RESC(); ROT();
  }
  #undef CMASK
  #define CMASK(P0,P1,t) do{}while(0)
  #define ENDW(tt) do{ if((tt)+3<NT){WAIT_BAR(2);} else if((tt)+2<NT){WAIT_BAR(1);} else {WAIT_BAR(0);} }while(0)
  for(;t+1<NT;t+=2){
    STEP(pB0,pB1,pA0,pA1,t,(t+3<NT),(t+1<NT),(t+1<NT));       ENDW(t);   RESC(); ROT();
    STEP(pA0,pA1,pB0,pB1,t+1,(t+4<NT),(t+2<NT),(t+2<NT));     ENDW(t+1); RESC(); ROT();
  }
  STEP(pB0,pB1,pA0,pA1,NT-1,false,false,false); RESC();
  { float sacc=pB0[0]+pB0[1]; _Pragma("unroll") for(int r=2;r<16;++r)sacc+=pB0[r]; _Pragma("unroll") for(int r=0;r<16;++r)sacc+=pB1[r]; l_reg+=sacc;
    pw0=(u32x4){PKW(pB0,0),PKW(pB0,2),PKW(pB0,4),PKW(pB0,6)};pw1=(u32x4){PKW(pB0,8),PKW(pB0,10),PKW(pB0,12),PKW(pB0,14)};pw2=(u32x4){PKW(pB1,0),PKW(pB1,2),PKW(pB1,4),PKW(pB1,6)};pw3=(u32x4){PKW(pB1,8),PKW(pB1,10),PKW(pB1,12),PKW(pB1,14)};
    SBAR(); pv(o,vb0+sl_cur,PAF(0),PAF(1),PAF(2),PAF(3)); }
  #undef PKW
  #undef PAF
  #undef VFR
  #undef PIN
  #undef MX3
  #undef GAPA
  #undef GAPB
  #undef EX
  #undef VRD
  #undef KRD
  #undef STEP
  #undef ENDW
  {auto rr=__builtin_amdgcn_permlane32_swap(__float_as_uint(l_reg),__float_as_uint(l_reg),false,false);l_reg=__uint_as_float(rr[0])+__uint_as_float(rr[1]);}
  if(hi==0)wsf[32+r32]=l_reg;asm volatile("s_waitcnt lgkmcnt(0)":::"memory");
  float rli[16];
  #pragma unroll
  for(int r=0;r<16;++r)rli[r]=__builtin_amdgcn_rcpf(wsf[32+crow(r,hi)]);
  bf16*Ow=O+(long)(row0+wid*QBLK)*OP+hq*D;
  { bf16*stg=(bf16*)(shm+LDS_OST)+wid*2048;
    #pragma unroll
    for(int r=0;r<16;++r){const int orow=crow(r,hi);
      #pragma unroll
      for(int d0=0;d0<2;++d0)stg[orow*64+d0*32+r32]=(bf16)(cvtpk_s(o[d0][r]*rli[r],0.f)&0xffffu);}
    asm volatile("s_waitcnt lgkmcnt(0)":::"memory");
    #pragma unroll
    for(int i=0;i<4;++i){const int row=i*8+(lane>>3),ch=lane&7; const u32x4 v=*(const u32x4*)(stg+row*64+ch*8); ATTN_STORE16(Ow+(long)row*OP+ch*8,v);} }
  asm volatile("s_waitcnt lgkmcnt(0)\n\ts_barrier":::"memory");
  #undef DMA_K
  #undef DMA_V
  #undef CMASK
  #undef START
  #undef RESC
  #undef ROT
}
constexpr int ATTN_LDS_BYTES=LDS_BYTES;
#undef SBAR
#undef WAIT_BAR
}

DEV void ph_attn_fast(const PV& p, const int l, int bid, int nb, unsigned char* smem) {
    const attn_body::bf16* Q = wsp<attn_body::bf16>(p, WS_AQ); const attn_body::bf16* K = wsp<attn_body::bf16>(p, WS_AK); const attn_body::bf16* V = wsp<attn_body::bf16>(p, WS_AV);
    attn_body::bf16* O = wsp<attn_body::bf16>(p, WS_Y) + 512;
    float gq, gk;
    { const int lane = p.tid() & 63; gq = fabsf(p.inp(I_AQG)[l * 64 + lane]); gk = fabsf(p.inp(I_AKG)[l * 64 + lane]);
      gq = fmaxf(gq, SWZ_XOR(gq, 0x041F)); gq = fmaxf(gq, SWZ_XOR(gq, 0x081F)); gq = fmaxf(gq, SWZ_XOR(gq, 0x101F)); gq = fmaxf(gq, SWZ_XOR(gq, 0x201F)); gq = fmaxf(gq, SWZ_XOR(gq, 0x401F));
      gk = fmaxf(gk, SWZ_XOR(gk, 0x041F)); gk = fmaxf(gk, SWZ_XOR(gk, 0x081F)); gk = fmaxf(gk, SWZ_XOR(gk, 0x101F)); gk = fmaxf(gk, SWZ_XOR(gk, 0x201F)); gk = fmaxf(gk, SWZ_XOR(gk, 0x401F));
      gq = fmaxf(RL(gq, 0), RL(gq, 32)); gk = fmaxf(RL(gk, 0), RL(gk, 32)); }
    const float bound = 64.f * attn_body::C2 * gq * gk * 1.05f;
    const bool nomax = bound <= 40.f;
    if (nomax) {
        for (int u = bid; u < 256; u += nb) { const int x = u & 7, hq = x >> 1, qb = (u >> 3) + 32 * (x & 1); attn_body::attn_unit<8, true>(hq, NC + 256 * qb, T / 64, Q, K, V, O, (char*)smem, p.z, p.tid()); }
        if (l == 0) for (int u = bid; u < 4; u += nb) attn_body::attn_unit<8, true>(u, 0, NC / 64, Q, K, V, O, (char*)smem, p.z, p.tid());
    } else {
        for (int u = bid; u < 256; u += nb) { const int x = u & 7, hq = x >> 1, qb = (u >> 3) + 32 * (x & 1); attn_body::attn_unit<8>(hq, NC + 256 * qb, T / 64, Q, K, V, O, (char*)smem, p.z, p.tid()); }
        if (l == 0) for (int u = bid; u < 4; u += nb) attn_body::attn_unit<8>(u, 0, NC / 64, Q, K, V, O, (char*)smem, p.z, p.tid());
    }
}

namespace mx {
using pg::cvt_pk_bf16;
typedef short bf16x8 __attribute__((ext_vector_type(8), may_alias));
typedef unsigned u32x4 __attribute__((ext_vector_type(4), may_alias));
typedef unsigned u32x2 __attribute__((ext_vector_type(2), may_alias));
constexpr int TS = 144, TILE_B = 64 * TS, WAVE_LDS = 2 * TILE_B + 1024;
constexpr int NCH = 260;
constexpr size_t WS_DSR = 191 * MiB, WS_SSR = 224 * MiB;
DEV int chunk_base(int dir, int s) { if (s < 4) return 64 * (dir ? 3 - s : s); const int ns = s - 4; return NC + 64 * (dir ? 255 - ns : ns); }
DEV int scan_index(int dir, int cn) { if (cn < 4) return dir ? 3 - cn : cn; const int c = cn - 4; return 4 + (dir ? 255 - c : c); }

template <bool INIT = false> DEV void mm64(f32x4 (&acc)[4][4], LAS const unsigned char* A, LAS const unsigned char* B, int lane) {
    const int r = lane & 15, q = lane >> 4;
#pragma unroll
    for (int ks = 0; ks < 2; ++ks) {
        bf16x8 a[4], b[4];
#pragma unroll
        for (int t = 0; t < 4; ++t) { a[t] = *(const LAS bf16x8*)(A + (16 * t + r) * TS + ks * 64 + q * 16); b[t] = *(const LAS bf16x8*)(B + (16 * t + r) * TS + ks * 64 + q * 16); }
#pragma unroll
        for (int mt = 0; mt < 4; ++mt)
#pragma unroll
            for (int nt = 0; nt < 4; ++nt) acc[mt][nt] = __builtin_amdgcn_mfma_f32_16x16x32_bf16(a[mt], b[nt], (INIT && ks == 0) ? (f32x4){0.f, 0.f, 0.f, 0.f} : acc[mt][nt], 0, 0, 0);
    }
}
template <bool INIT = false> DEV void mm32(f32x4 (&acc)[2][4], LAS const unsigned char* A, LAS const unsigned char* B, int lane, int mh) {
    const int r = lane & 15, q = lane >> 4;
#pragma unroll
    for (int ks = 0; ks < 2; ++ks) {
        bf16x8 a[2], b[4];
#pragma unroll
        for (int t = 0; t < 2; ++t) a[t] = *(const LAS bf16x8*)(A + (32 * mh + 16 * t + r) * TS + ks * 64 + q * 16);
#pragma unroll
        for (int t = 0; t < 4; ++t) b[t] = *(const LAS bf16x8*)(B + (16 * t + r) * TS + ks * 64 + q * 16);
#pragma unroll
        for (int mt = 0; mt < 2; ++mt)
#pragma unroll
            for (int nt = 0; nt < 4; ++nt) acc[mt][nt] = __builtin_amdgcn_mfma_f32_16x16x32_bf16(a[mt], b[nt], (INIT && ks == 0) ? (f32x4){0.f, 0.f, 0.f, 0.f} : acc[mt][nt], 0, 0, 0);
    }
}
DEV void zero_acc(f32x4 (&acc)[4][4], float zf) {
#pragma unroll
    for (int a = 0; a < 4; ++a)
#pragma unroll
        for (int b = 0; b < 4; ++b) acc[a][b] = (f32x4){zf, zf, zf, zf};
}
DEV void acc_to_tile_T(const f32x4 (&acc)[4][4], LAS unsigned char* tile, int lane) {
    const int r = lane & 15, q = lane >> 4;
#pragma unroll
    for (int mt = 0; mt < 4; ++mt)
#pragma unroll
        for (int nt = 0; nt < 4; ++nt) { u32x2 w; w.x = cvt_pk_bf16(acc[mt][nt][0], acc[mt][nt][1]); w.y = cvt_pk_bf16(acc[mt][nt][2], acc[mt][nt][3]);
            *(LAS u32x2*)(tile + (16 * nt + r) * TS + (16 * mt + 4 * q) * 2) = w; }
}
template <class F> DEV void stage_T(LAS unsigned char* tile, int lane, const F& f) {
#pragma unroll 1
    for (int hh = 0; hh < 2; ++hh) {
        unsigned pk[16];
#pragma unroll
        for (int i = 0; i < 32; i += 2) pk[i >> 1] = cvt_pk_bf16(f(hh * 32 + i), f(hh * 32 + i + 1));
#pragma unroll
        for (int c = 0; c < 4; ++c) { u32x4 w; w.x = pk[4 * c]; w.y = pk[4 * c + 1]; w.z = pk[4 * c + 2]; w.w = pk[4 * c + 3]; *(LAS u32x4*)(tile + lane * TS + hh * 64 + c * 16) = w; }
    }
}
DEV void stage_copy(LAS unsigned char* tile, int lane, const bf16_t* src) {
    u32x4 w[8];
#pragma unroll
    for (int c = 0; c < 8; ++c) w[c] = *(const u32x4*)(src + c * 8);
#pragma unroll
    for (int c = 0; c < 8; ++c) *(LAS u32x4*)(tile + lane * TS + c * 16) = w[c];
}
typedef unsigned short u16a __attribute__((may_alias));
template <bool DESC, class F> DEV void transpose_inplace(LAS unsigned char* tile, int lane, F& f) {
    unsigned raw[32];
#pragma unroll
    for (int i = 0; i < 64; i += 2) raw[i >> 1] = (unsigned)*(const LAS u16a*)(tile + i * TS + lane * 2) | ((unsigned)*(const LAS u16a*)(tile + (i + 1) * TS + lane * 2) << 16);
    if constexpr (!DESC) {
#pragma unroll
        for (int i = 0; i < 64; i += 2) { const float lo = f(i, __uint_as_float(raw[i >> 1] << 16)); const float hi = f(i + 1, __uint_as_float(raw[i >> 1] & 0xffff0000u)); raw[i >> 1] = cvt_pk_bf16(lo, hi); }
    } else {
#pragma unroll
        for (int i = 62; i >= 0; i -= 2) { const float hi = f(i + 1, __uint_as_float(raw[i >> 1] & 0xffff0000u)); const float lo = f(i, __uint_as_float(raw[i >> 1] << 16)); raw[i >> 1] = cvt_pk_bf16(lo, hi); }
    }
#pragma unroll
    for (int c = 0; c < 8; ++c) { u32x4 w; w.x = raw[4 * c]; w.y = raw[4 * c + 1]; w.z = raw[4 * c + 2]; w.w = raw[4 * c + 3]; *(LAS u32x4*)(tile + lane * TS + c * 16) = w; }
}
DEV void stage_rope(LAS unsigned char* tile, int lane, const bf16_t* src, int row, const float* RC, float scale) {
    float v[64];
#pragma unroll
    for (int c = 0; c < 8; ++c) { const u32x4 w = *(const u32x4*)(src + c * 8);
        v[8 * c] = __uint_as_float(w.x << 16); v[8 * c + 1] = __uint_as_float(w.x & 0xffff0000u); v[8 * c + 2] = __uint_as_float(w.y << 16); v[8 * c + 3] = __uint_as_float(w.y & 0xffff0000u);
        v[8 * c + 4] = __uint_as_float(w.z << 16); v[8 * c + 5] = __uint_as_float(w.z & 0xffff0000u); v[8 * c + 6] = __uint_as_float(w.w << 16); v[8 * c + 7] = __uint_as_float(w.w & 0xffff0000u); }
    {
        const int tl = row >= NC ? row - NC : 0;
#pragma unroll
        for (int a = 0; a < 2; ++a) { const int pos = a ? (tl & 63) : (tl >> 6);
#pragma unroll
            for (int j = 0; j < 16; ++j) { const float c = RC[pos * 16 + j], sn = RC[4096 + pos * 16 + j], x1 = v[a * 32 + j], x2 = v[a * 32 + 16 + j]; v[a * 32 + j] = x1 * c - x2 * sn; v[a * 32 + 16 + j] = x2 * c + x1 * sn; } }
    }
#pragma unroll
    for (int c = 0; c < 8; ++c) { u32x4 w; w.x = cvt_pk_bf16(v[8 * c] * scale, v[8 * c + 1] * scale); w.y = cvt_pk_bf16(v[8 * c + 2] * scale, v[8 * c + 3] * scale);
        w.z = cvt_pk_bf16(v[8 * c + 4] * scale, v[8 * c + 5] * scale); w.w = cvt_pk_bf16(v[8 * c + 6] * scale, v[8 * c + 7] * scale); *(LAS u32x4*)(tile + lane * TS + c * 16) = w; }
}
DEV int relane() { unsigned z; asm volatile("s_mov_b32 %0, 0" : "=s"(z)); return (int)__builtin_amdgcn_mbcnt_hi(~0u, __builtin_amdgcn_mbcnt_lo(~0u, z)); }
DEV float dpp_row_mirror(float x) { return __int_as_float(__builtin_amdgcn_update_dpp(0, __float_as_int(x), 0x140, 0xf, 0xf, true)); }

DEV void head_out(const PV& p, const float* gn, const f32x4 (&tot)[4][4], int nbase, int zgate, int ycol, int lane) {
    asm volatile("" : "+v"(lane));
    const bf16_t* Z = wsp<bf16_t>(p, WS_Z); bf16_t* Y = wsp<bf16_t>(p, WS_Y); const int r = lane & 15, q = lane >> 4;
#pragma unroll
    for (int nt = 0; nt < 4; ++nt) {
        float ss = 0.f;
#pragma unroll
        for (int mt = 0; mt < 4; ++mt) ss += tot[mt][nt][0] * tot[mt][nt][0] + tot[mt][nt][1] * tot[mt][nt][1] + tot[mt][nt][2] * tot[mt][nt][2] + tot[mt][nt][3] * tot[mt][nt][3];
        ss += SWZ_XOR(ss, 0x401F);
        { const auto rr = __builtin_amdgcn_permlane32_swap(__float_as_uint(ss), __float_as_uint(ss), false, false); ss = __uint_as_float(rr[0]) + __uint_as_float(rr[1]); }
        const float rs = rsqrtf(ss * (1.f / 64.f) + EPS);
        const int row = nbase + 16 * nt + r;
#pragma unroll
        for (int mt = 0; mt < 4; ++mt) { const int v0 = 16 * mt + 4 * q; const f32x4 g4 = *(const f32x4*)(gn + v0);
            const u32x2 gz = *(const u32x2*)(Z + (size_t)row * ZW + zgate + v0);
            const float z0 = __uint_as_float(gz.x << 16), z1 = __uint_as_float(gz.x & 0xffff0000u), z2 = __uint_as_float(gz.y << 16), z3 = __uint_as_float(gz.y & 0xffff0000u);
            u32x2 w; w.x = cvt_pk_bf16(tot[mt][nt][0] * rs * g4.x * z0 * pg::fsigm(z0), tot[mt][nt][1] * rs * g4.y * z1 * pg::fsigm(z1));
            w.y = cvt_pk_bf16(tot[mt][nt][2] * rs * g4.z * z2 * pg::fsigm(z2), tot[mt][nt][3] * rs * g4.w * z3 * pg::fsigm(z3));
            *(u32x2*)(Y + (size_t)row * 1024 + ycol + v0) = w; }
    }
}
DEV float ex2(float x) { return __builtin_amdgcn_exp2f(x); }
DEV float ret_lg2(int dir, int h) { const int hh = dir ? 3 - h : h; return __builtin_amdgcn_logf(1.f - ex2(-5.f - (float)hh)); }
DEV void ret_x1(const PV& p, int dir, int h, int s, LAS unsigned char* wl, int lane) {
    asm volatile("" : "+v"(lane));
    const bf16_t* Z = wsp<bf16_t>(p, WS_Z); const float* RC = wsp<float>(p, WS_ROPE);
    const int base = chunk_base(dir, s); const bool lat = base >= NC; const float lg2 = ret_lg2(dir, h);
    LAS unsigned char* t0 = wl; LAS unsigned char* t1 = wl + TILE_B;
    const int row_l = base + (dir ? 63 - lane : lane);
    stage_copy(t0, lane, Z + (size_t)row_l * ZW + ZC_RK + h * 64);
    stage_copy(t1, lane, Z + (size_t)row_l * ZW + ZC_RV + h * 64);
    { auto fk = [&](int i, float x) { const int row = base + (dir ? 63 - i : i);
          const int tl = lat ? row - NC : 0, pos = (lane >= 32) ? (tl & 63) : (tl >> 6), j = lane & 15; const float c = RC[pos * 16 + j], sn = RC[4096 + pos * 16 + j]; const float xp = SWZ_XOR(x, 0x401F);
          x = (lane & 16) ? x * c + xp * sn : x * c - xp * sn;
          return x * 0.125f * ex2((float)(63 - i) * lg2); };
      transpose_inplace<false>(t0, lane, fk); }
    { auto fv = [&](int i, float x) { return x; }; transpose_inplace<false>(t1, lane, fv); }
    f32x4 acc[4][4];
    mm64<true>(acc, t0, t1, lane);
    float* DS = wsp<float>(p, WS_DSR) + ((size_t)(dir * 4 + h) * NCH + s) * 4096;
    const int r = lane & 15, q = lane >> 4;
#pragma unroll
    for (int mt = 0; mt < 4; ++mt)
#pragma unroll
        for (int nt = 0; nt < 4; ++nt) *(f32x4*)(DS + (16 * nt + r) * 64 + 16 * mt + 4 * q) = acc[mt][nt];
}
DEV void ret_x2(const PV& p, int gt) {
    const int chain = gt >> 12, e = gt & 4095; const float decay = ex2(64.f * ret_lg2(chain >> 2, chain & 3));
    const float* DS = wsp<float>(p, WS_DSR) + (size_t)chain * NCH * 4096 + e; bf16_t* SS = wsp<bf16_t>(p, WS_SSR) + (size_t)chain * NCH * 4096 + e;
    float S = __uint_as_float(p.z);
    for (int s0 = 0; s0 < NCH; s0 += 52) { float d[52];
#pragma unroll
        for (int k = 0; k < 52; ++k) d[k] = DS[(size_t)(s0 + k) * 4096];
#pragma unroll
        for (int k = 0; k < 52; ++k) { SS[(size_t)(s0 + k) * 4096] = f2bf(S); S = decay * S + d[k]; } }
}
DEV void ret_x3(const PV& p, const int l, int h, int cn, LAS unsigned char* wl, int lane) {
    asm volatile("" : "+v"(lane));
    const bf16_t* Z = wsp<bf16_t>(p, WS_Z); const float* RC = wsp<float>(p, WS_ROPE); const float zf = __uint_as_float(p.z);
    const int nbase = cn < 4 ? 64 * cn : NC + 64 * (cn - 4); const int r = lane & 15, q = lane >> 4;
    LAS unsigned char* t0 = wl; LAS unsigned char* t1 = wl + TILE_B;
    const float lgf = ret_lg2(0, h), lgb = ret_lg2(1, h);
    const int row_l = nbase + lane;
    stage_rope(t0, lane, Z + (size_t)row_l * ZW + ZC_RK + h * 64, row_l, RC, 0.125f);
    stage_rope(t1, lane, Z + (size_t)row_l * ZW + ZC_RQ + h * 64, row_l, RC, 1.f);
    unsigned pk[4][4][2];
    { f32x4 accP[4][4]; mm64<true>(accP, t0, t1, lane);
#pragma unroll
      for (int mt = 0; mt < 4; ++mt)
#pragma unroll
        for (int nt = 0; nt < 4; ++nt) { float e[4];
#pragma unroll
            for (int g = 0; g < 4; ++g) { const int jj = 16 * mt + 4 * q + g, ii = 16 * nt + r;
                const int dd = ii - jj; float f = ex2((float)(dd > 0 ? dd : -dd) * (dd > 0 ? lgf : lgb)); f = dd == 0 ? 2.f : f; e[g] = accP[mt][nt][g] * f; }
            pk[mt][nt][0] = cvt_pk_bf16(e[0], e[1]); pk[mt][nt][1] = cvt_pk_bf16(e[2], e[3]); } }
    f32x4 tot[4][4];

    stage_copy(t0, lane, wsp<bf16_t>(p, WS_SSR) + ((size_t)(0 * 4 + h) * NCH + scan_index(0, cn)) * 4096 + lane * 64);
    mm64<true>(tot, t0, t1, lane);
#pragma unroll
    for (int nt = 0; nt < 4; ++nt) { const float f = ex2((float)(16 * nt + r + 1) * lgf);
#pragma unroll
        for (int mt = 0; mt < 4; ++mt) tot[mt][nt] *= f; }
    stage_copy(t0, lane, wsp<bf16_t>(p, WS_SSR) + ((size_t)(1 * 4 + h) * NCH + scan_index(1, cn)) * 4096 + lane * 64);
    { f32x4 accB[4][4]; mm64<true>(accB, t0, t1, lane);
#pragma unroll
      for (int nt = 0; nt < 4; ++nt) { const float f = ex2((float)(64 - 16 * nt - r) * lgb);
#pragma unroll
          for (int mt = 0; mt < 4; ++mt) tot[mt][nt] += accB[mt][nt] * f; } }
#pragma unroll
    for (int mt = 0; mt < 4; ++mt)
#pragma unroll
        for (int nt = 0; nt < 4; ++nt) { u32x2 w; w.x = pk[mt][nt][0]; w.y = pk[mt][nt][1]; *(LAS u32x2*)(t0 + (16 * nt + r) * TS + (16 * mt + 4 * q) * 2) = w; }
    stage_copy(t1, lane, Z + (size_t)row_l * ZW + ZC_RV + h * 64);
    { auto fv = [&](int i, float x) { return x; }; transpose_inplace<false>(t1, lane, fv); }
    mm64(tot, t1, t0, lane);
    head_out(p, p.inp(I_RNG) + l * 64, tot, nbase, ZC_RG + h * 64, h * 64, lane);
}

constexpr size_t WS_DSH = 505 * MiB, WS_SSH = 554 * MiB, WS_ACH = WS_SSH + 17 * MiB;
template <class F> DEV void stage_T_desc(LAS unsigned char* tile, int lane, F& f) {
#pragma unroll 1
    for (int hh = 1; hh >= 0; --hh) {
        unsigned pk[16];
#pragma unroll
        for (int i = 30; i >= 0; i -= 2) { const float hi = f(hh * 32 + i + 1); const float lo = f(hh * 32 + i); pk[i >> 1] = cvt_pk_bf16(lo, hi); }
#pragma unroll
        for (int c = 0; c < 4; ++c) { u32x4 w; w.x = pk[4 * c]; w.y = pk[4 * c + 1]; w.z = pk[4 * c + 2]; w.w = pk[4 * c + 3]; *(LAS u32x4*)(tile + lane * TS + hh * 64 + c * 16) = w; }
    }
}
DEV void hg_x1(const PV& p, const int l, int dir, int h, int s, LAS unsigned char* wl, int lane) {
    asm volatile("" : "+v"(lane));
    const bf16_t* Z = wsp<bf16_t>(p, WS_Z);
    const int base = chunk_base(dir, s), zc = (dir ? ZC_HFB : ZC_HFF) + h * 64 + lane;
    const float lb = wsp<float>(p, WS_LB)[(dir * 2 + l) * 256 + h * 64 + lane];
    LAS unsigned char* t0 = wl; LAS unsigned char* t1 = wl + TILE_B;
    const int row_l = base + (dir ? 63 - lane : lane);
    stage_copy(t0, lane, Z + (size_t)row_l * ZW + (dir ? ZC_HFB : ZC_HFF) + h * 64);
    stage_copy(t1, lane, Z + (size_t)row_l * ZW + ZC_HI + h * 64);
    float w = __uint_as_float(p.z);
    auto fk = [&](int i, float z) { const float f = lb + (1.f - lb) * pg::fsigm(z), k = (1.f - lb) * pg::fsigm(-z); const float val = k * ex2(w); w += __builtin_amdgcn_logf(f); return val; };
    transpose_inplace<true>(t0, lane, fk);
    const int chain = dir * 4 + h;
    wsp<float>(p, WS_ACH)[((size_t)chain * NCH + s) * 64 + lane] = ex2(w);
    { auto fv = [&](int i, float x) { return x; }; transpose_inplace<false>(t1, lane, fv); }
    f32x4 acc[4][4];
    mm64<true>(acc, t0, t1, lane);
    float* DS = wsp<float>(p, WS_DSH) + ((size_t)chain * NCH + s) * 4096;
    const int r = lane & 15, q = lane >> 4;
#pragma unroll
    for (int mt = 0; mt < 4; ++mt)
#pragma unroll
        for (int nt = 0; nt < 4; ++nt) *(f32x4*)(DS + (16 * nt + r) * 64 + 16 * mt + 4 * q) = acc[mt][nt];
}
DEV void hg_x2(const PV& p, int gt) {
    const int chain = gt >> 12, e = gt & 4095, d = e & 63;
    const float* DS = wsp<float>(p, WS_DSH) + (size_t)chain * NCH * 4096 + e; bf16_t* SS = wsp<bf16_t>(p, WS_SSH) + (size_t)chain * NCH * 4096 + e;
    const float* AC = wsp<float>(p, WS_ACH) + (size_t)chain * NCH * 64 + d;
    float S = __uint_as_float(p.z);
    for (int s0 = 0; s0 < NCH; s0 += 52) { float dd[52], aa[52];
#pragma unroll
        for (int k = 0; k < 52; ++k) { dd[k] = DS[(size_t)(s0 + k) * 4096]; aa[k] = AC[(s0 + k) * 64]; }
#pragma unroll
        for (int k = 0; k < 52; ++k) { SS[(size_t)(s0 + k) * 4096] = f2bf(S); S = aa[k] * S + dd[k]; } }
}
DEV void hg_x3(const PV& p, const int l, int h, int cn, LAS unsigned char* wl, int lane, float* park  ) {
    asm volatile("" : "+v"(lane));
    const bf16_t* Z = wsp<bf16_t>(p, WS_Z); const float zf = __uint_as_float(p.z);
    const int nbase = cn < 4 ? 64 * cn : NC + 64 * (cn - 4); const int r = lane & 15, q = lane >> 4;
    LAS unsigned char* t0 = wl; LAS unsigned char* t1 = wl + TILE_B; LAS float* misc = (LAS float*)(wl + 2 * TILE_B);
    f32x4 tot[4][4];
    unsigned pk[4][4][2];
    auto stageQK = [&](const int dir) {
        const float lb = wsp<float>(p, WS_LB)[(dir * 2 + l) * 256 + h * 64 + lane];
        stage_copy(t0, lane, Z + (size_t)(nbase + lane) * ZW + (dir ? ZC_HFB : ZC_HFF) + h * 64);
        stage_copy(t1, lane, Z + (size_t)(nbase + lane) * ZW + ZC_HQ + h * 64);
        float w = zf;
#pragma unroll 4
        for (int ip = 31; ip >= 0; --ip) { const int i = dir ? 63 - ip : ip;
            const float z = bf2f(*(const LAS u16a*)(t0 + i * TS + lane * 2)), zq = bf2f(*(const LAS u16a*)(t1 + i * TS + lane * 2));
            const float f = lb + (1.f - lb) * pg::fsigm(z), k = (1.f - lb) * pg::fsigm(-z), qq = zq * pg::fsigm(zq);
            *(LAS u16a*)(t0 + i * TS + lane * 2) = f2bf(k * ex2(w)); *(LAS u16a*)(t1 + i * TS + lane * 2) = f2bf(qq * ex2(-w));
            w += __builtin_amdgcn_logf(f); }
        misc[lane] = ex2(w);
        float w2 = zf;
#pragma unroll 4
        for (int ip = 32; ip < 64; ++ip) { const int i = dir ? 63 - ip : ip;
            const float z = bf2f(*(const LAS u16a*)(t0 + i * TS + lane * 2)), zq = bf2f(*(const LAS u16a*)(t1 + i * TS + lane * 2));
            const float f = lb + (1.f - lb) * pg::fsigm(z), k = (1.f - lb) * pg::fsigm(-z), qq = zq * pg::fsigm(zq);
            w2 += __builtin_amdgcn_logf(f);
            *(LAS u16a*)(t0 + i * TS + lane * 2) = f2bf(k * ex2(-w2)); *(LAS u16a*)(t1 + i * TS + lane * 2) = f2bf(qq * ex2(w2)); }
    };
    auto inter = [&](const int dir) {
        const bf16_t* src = wsp<bf16_t>(p, WS_SSH) + ((size_t)(dir * 4 + h) * NCH + scan_index(dir, cn)) * 4096 + lane * 64;
#pragma unroll
        for (int c8 = 0; c8 < 8; ++c8) { const pg::u32x4 w = *(const pg::u32x4*)(src + c8 * 8); const f32x4 e0 = *(const LAS f32x4*)(misc + c8 * 8), e1 = *(const LAS f32x4*)(misc + c8 * 8 + 4);
            u32x4 o; o.x = cvt_pk_bf16(__uint_as_float(w.x << 16) * e0.x, __uint_as_float(w.x & 0xffff0000u) * e0.y); o.y = cvt_pk_bf16(__uint_as_float(w.y << 16) * e0.z, __uint_as_float(w.y & 0xffff0000u) * e0.w);
            o.z = cvt_pk_bf16(__uint_as_float(w.z << 16) * e1.x, __uint_as_float(w.z & 0xffff0000u) * e1.y); o.w = cvt_pk_bf16(__uint_as_float(w.w << 16) * e1.z, __uint_as_float(w.w & 0xffff0000u) * e1.w);
            *(LAS u32x4*)(t0 + lane * TS + c8 * 16) = o; }
        mm64<true>(tot, t0, t1, lane);
    };
    stageQK(0);
    lane = relane();
#pragma unroll
    for (int mh = 0; mh < 2; ++mh) { f32x4 accP[2][4];
      mm32<true>(accP, t0, t1, lane, mh);
#pragma unroll
      for (int m2 = 0; m2 < 2; ++m2)
#pragma unroll
        for (int nt = 0; nt < 4; ++nt) { const int mt = 2 * mh + m2; float e[4];
#pragma unroll
            for (int g = 0; g < 4; ++g) { const int jj = 16 * mt + 4 * q + g, ii = 16 * nt + r; e[g] = jj <= ii ? accP[m2][nt][g] : 0.f; }
            pk[mt][nt][0] = cvt_pk_bf16(e[0], e[1]); pk[mt][nt][1] = cvt_pk_bf16(e[2], e[3]); } }
    lane = relane();
    inter(0);
    { float* pl = park + lane * 64;
#pragma unroll
      for (int mt = 0; mt < 4; ++mt)
#pragma unroll
        for (int nt = 0; nt < 4; ++nt) *(f32x4*)(pl + (mt * 4 + nt) * 4) = tot[mt][nt]; }
    lane = relane();
    stageQK(1);
    lane = relane();
#pragma unroll
    for (int mh = 0; mh < 2; ++mh) { f32x4 accP[2][4];
      mm32<true>(accP, t0, t1, lane, mh);
#pragma unroll
      for (int m2 = 0; m2 < 2; ++m2)
#pragma unroll
        for (int nt = 0; nt < 4; ++nt) { const int mt = 2 * mh + m2; float e[4];
            e[0] = __uint_as_float(pk[mt][nt][0] << 16); e[1] = __uint_as_float(pk[mt][nt][0] & 0xffff0000u); e[2] = __uint_as_float(pk[mt][nt][1] << 16); e[3] = __uint_as_float(pk[mt][nt][1] & 0xffff0000u);
#pragma unroll
            for (int g = 0; g < 4; ++g) { const int jj = 16 * mt + 4 * q + g, ii = 16 * nt + r; e[g] += jj >= ii ? accP[m2][nt][g] : 0.f; }
            pk[mt][nt][0] = cvt_pk_bf16(e[0], e[1]); pk[mt][nt][1] = cvt_pk_bf16(e[2], e[3]); } }
    lane = relane();
    inter(1);
    lane = relane();
#pragma unroll
    for (int mt = 0; mt < 4; ++mt)
#pragma unroll
        for (int nt = 0; nt < 4; ++nt) { u32x2 w; w.x = pk[mt][nt][0]; w.y = pk[mt][nt][1]; *(LAS u32x2*)(t0 + (16 * nt + r) * TS + (16 * mt + 4 * q) * 2) = w; }
    stage_copy(t1, lane, Z + (size_t)(nbase + lane) * ZW + ZC_HI + h * 64);
    { auto fv = [&](int i, float x) { return x; }; transpose_inplace<false>(t1, lane, fv); }
    mm64(tot, t1, t0, lane);
    { const float* pp = park + lane * 64; asm volatile("" : "+v"(pp) : "v"(tot[3][3][3]));
#pragma unroll
      for (int mt = 0; mt < 4; ++mt)
#pragma unroll
        for (int nt = 0; nt < 4; ++nt) tot[mt][nt] += *(const f32x4*)(pp + (mt * 4 + nt) * 4); }
    head_out(p, p.inp(I_HNG) + l * 64, tot, nbase, ZC_HG + h * 64, 256 + h * 64, lane);
}
constexpr size_t WS_PARK2 = 191 * MiB;
constexpr size_t WS_PARK = 191 * MiB;
constexpr size_t WS_MCG = 409 * MiB, WS_BCG = 426 * MiB, WS_UTG = 459 * MiB, WS_WNG = 476 * MiB, WS_CGG = 493 * MiB, WS_SSG = 537 * MiB + 512 * 1024;
template <int I> DEV void solve_rows(float (&x)[64], LAS const unsigned char* At) {
    if constexpr (I < 64) {
        float a[4] = {x[I], 0.f, 0.f, 0.f};
        int dep = 0;
        if constexpr (I >= 6) asm("v_and_b32 %0, 0, %1" : "=v"(dep) : "v"(x[I - 6]));
#pragma unroll
        for (int m8 = 0; m8 < (I + 7) / 8; ++m8) { const u32x4 w = *(const LAS u32x4*)(At + I * TS + dep + m8 * 16);
            const float a0 = __uint_as_float(w.x << 16), a1 = __uint_as_float(w.x & 0xffff0000u), a2 = __uint_as_float(w.y << 16), a3 = __uint_as_float(w.y & 0xffff0000u),
                        a4 = __uint_as_float(w.z << 16), a5 = __uint_as_float(w.z & 0xffff0000u), a6 = __uint_as_float(w.w << 16), a7 = __uint_as_float(w.w & 0xffff0000u);
            if (m8 * 8 + 0 < I) a[0] -= a0 * x[m8 * 8 + 0]; if (m8 * 8 + 1 < I) a[1] -= a1 * x[m8 * 8 + 1]; if (m8 * 8 + 2 < I) a[2] -= a2 * x[m8 * 8 + 2]; if (m8 * 8 + 3 < I) a[3] -= a3 * x[m8 * 8 + 3];
            if (m8 * 8 + 4 < I) a[0] -= a4 * x[m8 * 8 + 4]; if (m8 * 8 + 5 < I) a[1] -= a5 * x[m8 * 8 + 5]; if (m8 * 8 + 6 < I) a[2] -= a6 * x[m8 * 8 + 6]; if (m8 * 8 + 7 < I) a[3] -= a7 * x[m8 * 8 + 7]; }
        x[I] = (a[0] + a[1]) + (a[2] + a[3]);
        solve_rows<I + 1>(x, At);
    }
}
typedef float f32x2_t __attribute__((ext_vector_type(2)));
constexpr int tri_off(int i) { return 4 * ((i >> 2) + 1) * (2 * (i >> 2) + (i & 3)); }
static_assert(tri_off(63) + 64 <= TILE_B / 4, "packed triangle fits a tile region");
template <int I> DEV void solve2_rows(f32x2_t (&x)[64], LAS const float* At) {
    if constexpr (I < 64) {
        f32x2_t a0 = x[I], a1 = {0.f, 0.f}, a2 = {0.f, 0.f}, a3 = {0.f, 0.f};
        int dep = 0;
        if constexpr (I >= 24) asm("v_and_b32 %0, 0, %1" : "=v"(dep) : "v"(x[I - 1].x));
        else if constexpr (I >= 3) asm("v_and_b32 %0, 0, %1" : "=v"(dep) : "v"(x[I - 3].x));
        LAS const float* row = At + tri_off(I) + dep;
#pragma unroll
        for (int m4 = 0; m4 < (I + 3) / 4; ++m4) { const f32x4 w = *(const LAS f32x4*)(row + 4 * m4);
            if (4 * m4 + 0 < I) a0 -= w.x * x[4 * m4 + 0]; if (4 * m4 + 1 < I) a1 -= w.y * x[4 * m4 + 1]; if (4 * m4 + 2 < I) a2 -= w.z * x[4 * m4 + 2]; if (4 * m4 + 3 < I) a3 -= w.w * x[4 * m4 + 3]; }
        x[I] = (a0 + a1) + (a2 + a3);
        solve2_rows<I + 1>(x, At);
    }
}
template <int I> DEV void solve2b_rows(f32x2_t (&x)[64], LAS const unsigned char* At) {
    if constexpr (I < 64) {
        f32x2_t a0 = x[I], a1 = {0.f, 0.f}, a2 = {0.f, 0.f}, a3 = {0.f, 0.f};
        int dep = 0;
        if constexpr (I >= 3) asm("v_and_b32 %0, 0, %1" : "=v"(dep) : "v"(x[I - 3].x));
#pragma unroll
        for (int m8 = 0; m8 < (I + 7) / 8; ++m8) { const u32x4 w = *(const LAS u32x4*)(At + I * TS + dep + m8 * 16);
            const float e0 = __uint_as_float(w.x << 16), e1 = __uint_as_float(w.x & 0xffff0000u), e2 = __uint_as_float(w.y << 16), e3 = __uint_as_float(w.y & 0xffff0000u),
                        e4 = __uint_as_float(w.z << 16), e5 = __uint_as_float(w.z & 0xffff0000u), e6 = __uint_as_float(w.w << 16), e7 = __uint_as_float(w.w & 0xffff0000u);
            if (m8 * 8 + 0 < I) a0 -= e0 * x[m8 * 8 + 0]; if (m8 * 8 + 1 < I) a1 -= e1 * x[m8 * 8 + 1]; if (m8 * 8 + 2 < I) a2 -= e2 * x[m8 * 8 + 2]; if (m8 * 8 + 3 < I) a3 -= e3 * x[m8 * 8 + 3];
            if (m8 * 8 + 4 < I) a0 -= e4 * x[m8 * 8 + 4]; if (m8 * 8 + 5 < I) a1 -= e5 * x[m8 * 8 + 5]; if (m8 * 8 + 6 < I) a2 -= e6 * x[m8 * 8 + 6]; if (m8 * 8 + 7 < I) a3 -= e7 * x[m8 * 8 + 7]; }
        x[I] = (a0 + a1) + (a2 + a3);
        solve2b_rows<I + 1>(x, At);
    }
}
template <int dir> DEV void gdn_x1(const PV& p, const int l, int h, int s, LAS unsigned char* wl, int lane) {
    asm volatile("" : "+v"(lane));
    const float zf = __uint_as_float(p.z);
    const bf16_t* GQ = wsp<bf16_t>(p, WS_GQKV); const float* GATE = wsp<float>(p, WS_GATE);
    const int base = chunk_base(dir, s), chain = dir * 4 + h; const size_t unit = (size_t)chain * NCH + s;
    const int r = lane & 15, q = lane >> 4;
    LAS unsigned char* t0 = wl; LAS unsigned char* t1 = wl + TILE_B; LAS float* misc = (LAS float*)(wl + 2 * TILE_B);
    const int row_l = base + (dir ? 63 - lane : lane);
    {
        const float Aexp = ex2(p.inp(I_ALOG)[(l * 2 + dir) * 4 + h] * 1.4426950408889634f), dtb = p.inp(I_DTB)[(l * 2 + dir) * 4 + h];
        const float av = GATE[(size_t)row_l * 16 + dir * 4 + h] + dtb, bv = GATE[(size_t)row_l * 16 + 8 + dir * 4 + h];
        const float ey = ex2(av * 1.4426950408889634f);
        const float sp = av > 20.f ? av : (ey < 0.01f ? ey * (1.f - ey * (0.5f - ey * (1.f / 3.f))) : __builtin_amdgcn_logf(1.f + ey) * 0.6931471805599453f);
        const float g2 = -Aexp * sp * 1.4426950408889634f;
        misc[128 + lane] = g2; misc[64 + lane] = pg::fsigm(bv);
        float c = zf;
#pragma unroll 8
        for (int m = 0; m < 64; ++m) { const float gm = misc[128 + m]; c += (m <= lane) ? gm : 0.f; }
        misc[lane] = c;
        wsp<float>(p, WS_CGG)[unit * 64 + (dir ? 63 - lane : lane)] = c;
    }
    stage_copy(t0, lane, GQ + ((size_t)1 * T + row_l) * 256 + h * 64);
    stage_copy(t1, lane, GQ + ((size_t)2 * T + row_l) * 256 + h * 64);
    unsigned vcol[32];
#pragma unroll
    for (int i = 0; i < 64; i += 2) vcol[i >> 1] = (unsigned)*(const LAS u16a*)(t1 + i * TS + lane * 2) | ((unsigned)*(const LAS u16a*)(t1 + (i + 1) * TS + lane * 2) << 16);
    {
        f32x4 acc[4][4]; mm64<true>(acc, t0, t0, lane);
#pragma unroll
        for (int mt = 0; mt < 4; ++mt) { const f32x4 cgm = *(const LAS f32x4*)(misc + 16 * mt + 4 * q), bem = *(const LAS f32x4*)(misc + 64 + 16 * mt + 4 * q);
#pragma unroll
            for (int nt = 0; nt < 4; ++nt) { const float cgn = misc[16 * nt + r];
#pragma unroll
                for (int g = 0; g < 4; ++g) { const int ii = 16 * mt + 4 * q + g, jj = 16 * nt + r; const float a = jj < ii ? bem[g] * acc[mt][nt][g] * ex2(cgm[g] - cgn) : 0.f;
                    *(LAS u16a*)(t1 + ii * TS + jj * 2) = f2bf(a); } } }
    }
    lane = relane();
    unsigned upk[32];
    {
        f32x2_t x[64];
        LAS const float* mp = misc; asm volatile("" : "+v"(mp));
#pragma unroll
        for (int i = 0; i < 64; ++i) { const float be = mp[64 + i];
            x[i].x = be * ex2(mp[i]) * bf2f(*(const LAS u16a*)(t0 + i * TS + lane * 2));
            x[i].y = be * __uint_as_float((i & 1) ? (vcol[i >> 1] & 0xffff0000u) : (vcol[i >> 1] << 16)); }
        solve2b_rows<1>(x, t1);
        lane = relane();
        {
            bf16_t* WN = wsp<bf16_t>(p, WS_WNG) + unit * 4096 + lane;
#pragma unroll
            for (int i = 0; i < 64; ++i) WN[(dir ? 63 - i : i) * 64] = f2bf(x[i].x);
#pragma unroll
            for (int c = 0; c < 8; ++c) { u32x4 w; w.x = cvt_pk_bf16(x[8 * c].x, x[8 * c + 1].x); w.y = cvt_pk_bf16(x[8 * c + 2].x, x[8 * c + 3].x); w.z = cvt_pk_bf16(x[8 * c + 4].x, x[8 * c + 5].x); w.w = cvt_pk_bf16(x[8 * c + 6].x, x[8 * c + 7].x);
                *(LAS u32x4*)(t0 + lane * TS + c * 16) = w; }
        }
        {
#pragma unroll
            for (int i = 0; i < 32; ++i) upk[i] = cvt_pk_bf16(x[2 * i].y, x[2 * i + 1].y);
            pg::u32x4* UT = (pg::u32x4*)(wsp<bf16_t>(p, WS_UTG) + unit * 4096 + lane * 64);
#pragma unroll
            for (int c = 0; c < 8; ++c) { pg::u32x4 w; w.x = upk[4 * c]; w.y = upk[4 * c + 1]; w.z = upk[4 * c + 2]; w.w = upk[4 * c + 3]; UT[c] = w; }
        }
    }
    lane = relane();
    const float cg63 = misc[63];
    stage_copy(t1, lane, GQ + ((size_t)1 * T + base + (dir ? 63 - lane : lane)) * 256 + h * 64);
    { auto fkt = [&](int i, float x) { return x * ex2(cg63 - misc[i]); }; transpose_inplace<false>(t1, lane, fkt); }
    {   f32x4 acc[4][4]; mm64<true>(acc, t0, t1, lane);
        const float ac = ex2(cg63); bf16_t* MC = wsp<bf16_t>(p, WS_MCG) + unit * 4096;
#pragma unroll
        for (int mt = 0; mt < 4; ++mt)
#pragma unroll
            for (int nt = 0; nt < 4; ++nt) { float e[4];
#pragma unroll
                for (int g = 0; g < 4; ++g) e[g] = ((16 * mt + 4 * q + g) == (16 * nt + r) ? ac : 0.f) - acc[mt][nt][g];
                pg::u32x2 w; w.x = cvt_pk_bf16(e[0], e[1]); w.y = cvt_pk_bf16(e[2], e[3]);
                *(pg::u32x2*)(MC + (16 * nt + r) * 64 + 32 * (mt >> 1) + 8 * q + 4 * (mt & 1)) = w; } }
#pragma unroll
    for (int c = 0; c < 8; ++c) { u32x4 w; w.x = upk[4 * c]; w.y = upk[4 * c + 1]; w.z = upk[4 * c + 2]; w.w = upk[4 * c + 3]; *(LAS u32x4*)(t0 + lane * TS + c * 16) = w; }
    {   f32x4 acc[4][4]; mm64<true>(acc, t1, t0, lane);
        float* BC = wsp<float>(p, WS_BCG) + unit * 4096;
#pragma unroll
        for (int mt = 0; mt < 4; ++mt)
#pragma unroll
            for (int nt = 0; nt < 4; ++nt) *(f32x4*)(BC + (16 * nt + r) * 64 + 16 * mt + 4 * q) = acc[mt][nt]; }
}
constexpr int GSZ = 13, NGRP = NCH / GSZ;
constexpr size_t WS_PGG = 494 * MiB, WS_RGG = 496 * MiB, WS_SGG = 499 * MiB;
static_assert(NGRP * GSZ == NCH, "groups");
DEV void scan_step(pg::bf16x8 (&sb)[2], const bf16_t* mrow  , const float* cin  ) {
    f32x4 c[4]; pg::bf16x8 a[4][2];
#pragma unroll
    for (int mt = 0; mt < 4; ++mt) { c[mt] = cin ? *(const f32x4*)(cin + 16 * mt) : (f32x4){0.f, 0.f, 0.f, 0.f};
#pragma unroll
        for (int ks = 0; ks < 2; ++ks) a[mt][ks] = *(const pg::bf16x8*)(mrow + 16 * mt * 64 + 32 * ks); }
#pragma unroll
    for (int mt = 0; mt < 4; ++mt) { c[mt] = __builtin_amdgcn_mfma_f32_16x16x32_bf16(a[mt][0], sb[0], c[mt], 0, 0, 0); c[mt] = __builtin_amdgcn_mfma_f32_16x16x32_bf16(a[mt][1], sb[1], c[mt], 0, 0, 0); }
#pragma unroll
    for (int ks = 0; ks < 2; ++ks) { pg::u32x4 w; w.x = cvt_pk_bf16(c[2 * ks][0], c[2 * ks][1]); w.y = cvt_pk_bf16(c[2 * ks][2], c[2 * ks][3]); w.z = cvt_pk_bf16(c[2 * ks + 1][0], c[2 * ks + 1][1]); w.w = cvt_pk_bf16(c[2 * ks + 1][2], c[2 * ks + 1][3]);
        sb[ks] = __builtin_bit_cast(pg::bf16x8, w); }
}
DEV void state_store(const pg::bf16x8 (&sb)[2], bf16_t* dst  ) {
#pragma unroll
    for (int mt = 0; mt < 4; ++mt) { const pg::u32x4 w = __builtin_bit_cast(pg::u32x4, sb[mt >> 1]); pg::u32x2 o; o.x = (mt & 1) ? w.z : w.x; o.y = (mt & 1) ? w.w : w.y; *(pg::u32x2*)(dst + 16 * mt) = o; }
}
DEV void state_load(pg::bf16x8 (&sb)[2], const bf16_t* src) {
#pragma unroll
    for (int ks = 0; ks < 2; ++ks) { const pg::u32x2 lo = *(const pg::u32x2*)(src + 32 * ks), hi = *(const pg::u32x2*)(src + 32 * ks + 16); pg::u32x4 w; w.x = lo.x; w.y = lo.y; w.z = hi.x; w.w = hi.y; sb[ks] = __builtin_bit_cast(pg::bf16x8, w); }
}
template <int N, int DEPTH, bool USEC = true, class F> DEV void scan_run(pg::bf16x8 (&sb)[2], const bf16_t* mrow, const float* cin, F&& before) {
    constexpr int S = DEPTH + 1;
    pg::bf16x8 a[S][4][2]; f32x4 c[S][4];
#define SCAN_LD(slot, t) do { _Pragma("unroll") for (int mt_ = 0; mt_ < 4; ++mt_) { if constexpr (USEC) c[slot][mt_] = *(const f32x4*)(cin + (size_t)(t) * 4096 + 16 * mt_); \
        _Pragma("unroll") for (int ks_ = 0; ks_ < 2; ++ks_) a[slot][mt_][ks_] = *(const pg::bf16x8*)(mrow + (size_t)(t) * 4096 + 16 * mt_ * 64 + 32 * ks_); } } while (0)
#pragma unroll
    for (int t = 0; t < DEPTH; ++t) if (t < N) SCAN_LD(t % S, t);
    __builtin_amdgcn_sched_barrier(0);
#pragma unroll
    for (int t = 0; t < N; ++t) {
        if (t + DEPTH < N) { SCAN_LD((t + DEPTH) % S, t + DEPTH); __builtin_amdgcn_sched_barrier(0); }
        before(t);
        const int sl = t % S; f32x4 cc[4];
#pragma unroll
        for (int mt = 0; mt < 4; ++mt) { cc[mt] = __builtin_amdgcn_mfma_f32_16x16x32_bf16(a[sl][mt][0], sb[0], USEC ? c[sl][mt] : (f32x4){0.f, 0.f, 0.f, 0.f}, 0, 0, 0); cc[mt] = __builtin_amdgcn_mfma_f32_16x16x32_bf16(a[sl][mt][1], sb[1], cc[mt], 0, 0, 0); }
#pragma unroll
        for (int ks = 0; ks < 2; ++ks) { pg::u32x4 w; w.x = cvt_pk_bf16(cc[2 * ks][0], cc[2 * ks][1]); w.y = cvt_pk_bf16(cc[2 * ks][2], cc[2 * ks][3]); w.z = cvt_pk_bf16(cc[2 * ks + 1][0], cc[2 * ks + 1][1]); w.w = cvt_pk_bf16(cc[2 * ks + 1][2], cc[2 * ks + 1][3]);
            sb[ks] = __builtin_bit_cast(pg::bf16x8, w); }
        __builtin_amdgcn_sched_barrier(0);
    }
#undef SCAN_LD
}
DEV void gdn_l1(const PV& p, int chain, int grp, int wave, int lane) {
    const int r = lane & 15, q = lane >> 4, isr = wave >> 2, col = (wave & 3) * 16 + r;
    const size_t u0 = (size_t)chain * NCH + grp * GSZ;
    const bf16_t* MC = wsp<bf16_t>(p, WS_MCG) + u0 * 4096 + r * 64 + 8 * q; const float* BC = wsp<float>(p, WS_BCG) + u0 * 4096 + col * 64 + 4 * q;
    pg::bf16x8 sb[2];
#pragma unroll
    for (int ks = 0; ks < 2; ++ks)
#pragma unroll
        for (int j = 0; j < 8; ++j) { const int row = 16 * (2 * ks + (j >> 2)) + 4 * q + (j & 3); sb[ks][j] = (short)((!isr && row == col) ? 0x3f80 : 0); }
    { auto nop = [](int) {};
      if (isr) scan_run<GSZ, 3, true>(sb, MC, BC, nop); else scan_run<GSZ, 3, false>(sb, MC, BC, nop); }
    const size_t g = (size_t)chain * NGRP + grp;
    if (isr) {
        float* RG = wsp<float>(p, WS_RGG) + g * 4096 + col * 64 + 4 * q;
#pragma unroll
        for (int mt = 0; mt < 4; ++mt) { const pg::u32x4 w = __builtin_bit_cast(pg::u32x4, sb[mt >> 1]); const unsigned w0 = (mt & 1) ? w.z : w.x, w1 = (mt & 1) ? w.w : w.y;
            *(f32x4*)(RG + 16 * mt) = (f32x4){__uint_as_float(w0 << 16), __uint_as_float(w0 & 0xffff0000u), __uint_as_float(w1 << 16), __uint_as_float(w1 & 0xffff0000u)}; }
    } else {
        bf16_t* PGm = wsp<bf16_t>(p, WS_PGG) + g * 4096; const int w4 = wave & 3, pic = 32 * (w4 >> 1) + 8 * (r >> 2) + 4 * (w4 & 1) + (r & 3);
#pragma unroll
        for (int ks = 0; ks < 2; ++ks)
#pragma unroll
            for (int j = 0; j < 8; ++j) { const int row = 16 * (2 * ks + (j >> 2)) + 4 * q + (j & 3); PGm[row * 64 + pic] = (bf16_t)sb[ks][j]; }
    }
}
template <bool ISR> DEV void l1_chain(pg::bf16x8 (&sb)[2], LAS const unsigned char* arow, const float* BC) {
    f32x4 cq[3][4];
    if constexpr (ISR) {
#pragma unroll
        for (int t = 0; t < 2; ++t)
#pragma unroll
            for (int mt = 0; mt < 4; ++mt) cq[t][mt] = *(const f32x4*)(BC + (size_t)t * 4096 + 16 * mt);
    }
#pragma unroll
    for (int t = 0; t < GSZ; ++t) {
        if constexpr (ISR) { if (t + 2 < GSZ) {
#pragma unroll
            for (int mt = 0; mt < 4; ++mt) cq[(t + 2) % 3][mt] = *(const f32x4*)(BC + (size_t)(t + 2) * 4096 + 16 * mt); } }
        f32x4 cc[4];
#pragma unroll
        for (int mt = 0; mt < 4; ++mt) { const bf16x8 a0 = *(const LAS bf16x8*)(arow + t * TILE_B + mt * 16 * TS), a1 = *(const LAS bf16x8*)(arow + t * TILE_B + mt * 16 * TS + 64);
            f32x4 c0; if constexpr (ISR) c0 = cq[t % 3][mt]; else c0 = (f32x4){0.f, 0.f, 0.f, 0.f};
            cc[mt] = __builtin_amdgcn_mfma_f32_16x16x32_bf16(__builtin_bit_cast(pg::bf16x8, a0), sb[0], c0, 0, 0, 0);
            cc[mt] = __builtin_amdgcn_mfma_f32_16x16x32_bf16(__builtin_bit_cast(pg::bf16x8, a1), sb[1], cc[mt], 0, 0, 0); }
#pragma unroll
        for (int ks = 0; ks < 2; ++ks) { pg::u32x4 w; w.x = cvt_pk_bf16(cc[2 * ks][0], cc[2 * ks][1]); w.y = cvt_pk_bf16(cc[2 * ks][2], cc[2 * ks][3]); w.z = cvt_pk_bf16(cc[2 * ks + 1][0], cc[2 * ks + 1][1]); w.w = cvt_pk_bf16(cc[2 * ks + 1][2], cc[2 * ks + 1][3]);
            sb[ks] = __builtin_bit_cast(pg::bf16x8, w); }
    }
}
DEV void gdn_l1_lds(const PV& p, int chain, int grp, int wave, int lane, LAS unsigned char* lds, int tid) {
    const int r = lane & 15, q = lane >> 4, isr = wave >> 2, col = (wave & 3) * 16 + r;
    const size_t u0 = (size_t)chain * NCH + grp * GSZ;
    {   const bf16_t* MCt = wsp<bf16_t>(p, WS_MCG) + u0 * 4096 + (tid >> 3) * 64 + (tid & 7) * 8;
        u32x4 w[GSZ];
#pragma unroll
        for (int k = 0; k < GSZ; ++k) w[k] = *(const u32x4*)(MCt + (size_t)k * 4096);
#pragma unroll
        for (int k = 0; k < GSZ; ++k) *(LAS u32x4*)(lds + k * TILE_B + (tid >> 3) * TS + (tid & 7) * 16) = w[k];
    }
    __syncthreads();
    const float* BC = wsp<float>(p, WS_BCG) + u0 * 4096 + col * 64 + 4 * q;
    pg::bf16x8 sb[2];
#pragma unroll
    for (int ks = 0; ks < 2; ++ks)
#pragma unroll
        for (int j = 0; j < 8; ++j) { const int row = 16 * (2 * ks + (j >> 2)) + 4 * q + (j & 3); sb[ks][j] = (short)((!isr && row == col) ? 0x3f80 : 0); }
    LAS const unsigned char* arow = lds + r * TS + q * 16;
    if (isr) l1_chain<true>(sb, arow, BC); else l1_chain<false>(sb, arow, BC);
    const size_t g = (size_t)chain * NGRP + grp;
    if (isr) {
        float* RG = wsp<float>(p, WS_RGG) + g * 4096 + col * 64 + 4 * q;
#pragma unroll
        for (int mt = 0; mt < 4; ++mt) { const pg::u32x4 w = __builtin_bit_cast(pg::u32x4, sb[mt >> 1]); const unsigned w0 = (mt & 1) ? w.z : w.x, w1 = (mt & 1) ? w.w : w.y;
            *(f32x4*)(RG + 16 * mt) = (f32x4){__uint_as_float(w0 << 16), __uint_as_float(w0 & 0xffff0000u), __uint_as_float(w1 << 16), __uint_as_float(w1 & 0xffff0000u)}; }
    } else {
        bf16_t* PGm = wsp<bf16_t>(p, WS_PGG) + g * 4096; const int w4 = wave & 3, pic = 32 * (w4 >> 1) + 8 * (r >> 2) + 4 * (w4 & 1) + (r & 3);
#pragma unroll
        for (int ks = 0; ks < 2; ++ks)
#pragma unroll
            for (int j = 0; j < 8; ++j) { const int row = 16 * (2 * ks + (j >> 2)) + 4 * q + (j & 3); PGm[row * 64 + pic] = (bf16_t)sb[ks][j]; }
    }
}
DEV void gdn_l2(const PV& p, int chain, int vg, int lane) {
    const int r = lane & 15, q = lane >> 4, col = vg * 16 + r; const size_t g0 = (size_t)chain * NGRP;
    const bf16_t* PGm = wsp<bf16_t>(p, WS_PGG) + g0 * 4096 + r * 64 + 8 * q; const float* RG = wsp<float>(p, WS_RGG) + g0 * 4096 + col * 64 + 4 * q;
    bf16_t* SG = wsp<bf16_t>(p, WS_SGG) + g0 * 4096 + col * 64 + 4 * q;
    pg::bf16x8 sb[2];
#pragma unroll
    for (int ks = 0; ks < 2; ++ks)
#pragma unroll
        for (int j = 0; j < 8; ++j) sb[ks][j] = (short)p.z;
#pragma unroll
    for (int g = 0; g < NGRP; ++g) { state_store(sb, SG + (size_t)g * 4096); if (g + 1 < NGRP) scan_step(sb, PGm + (size_t)g * 4096, RG + (size_t)g * 4096); }
}
DEV void gdn_l3(const PV& p, int chain, int grp, int vg, int lane) {
    const int r = lane & 15, q = lane >> 4, col = vg * 16 + r; const size_t u0 = (size_t)chain * NCH + grp * GSZ;
    const bf16_t* MC = wsp<bf16_t>(p, WS_MCG) + u0 * 4096 + r * 64 + 8 * q; const float* BC = wsp<float>(p, WS_BCG) + u0 * 4096 + col * 64 + 4 * q;
    bf16_t* SS = wsp<bf16_t>(p, WS_SSG) + u0 * 4096 + col * 64 + 4 * q;
    pg::bf16x8 sb[2]; state_load(sb, wsp<bf16_t>(p, WS_SGG) + ((size_t)chain * NGRP + grp) * 4096 + col * 64 + 4 * q);
#pragma unroll
    for (int t = 0; t < GSZ; ++t) { state_store(sb, SS + (size_t)t * 4096); if (t + 1 < GSZ) scan_step(sb, MC + (size_t)t * 4096, BC + (size_t)t * 4096); }
}
DEV void gdn_x3(const PV& p, const int l, int h, int cn, LAS unsigned char* wl, int lane, float* park  ) {
    asm volatile("" : "+v"(lane));
    const bf16_t* GQ = wsp<bf16_t>(p, WS_GQKV);
    const int nbase = cn < 4 ? 64 * cn : NC + 64 * (cn - 4); const int r = lane & 15, q = lane >> 4;
    LAS unsigned char* t0 = wl; LAS unsigned char* t1 = wl + TILE_B; LAS float* misc = (LAS float*)(wl + 2 * TILE_B);
    const int row_l = nbase + lane;
#pragma unroll 1
    for (int dir = 0; dir < 2; ++dir) {
        const size_t un = (size_t)(dir * 4 + h) * NCH + scan_index(dir, cn);
        misc[lane] = wsp<float>(p, WS_CGG)[un * 64 + lane];
        stage_copy(t0, lane, GQ + ((size_t)1 * T + row_l) * 256 + h * 64);
        stage_copy(t1, lane, GQ + ((size_t)0 * T + row_l) * 256 + h * 64);
        unsigned pk[4][4][2];
#pragma unroll
        for (int mh = 0; mh < 2; ++mh) { f32x4 acc[2][4]; mm32<true>(acc, t0, t1, lane, mh);
#pragma unroll
            for (int m2 = 0; m2 < 2; ++m2) { const int mt = 2 * mh + m2; const f32x4 cgm = *(const LAS f32x4*)(misc + 16 * mt + 4 * q);
#pragma unroll
                for (int nt = 0; nt < 4; ++nt) { const float cgn = misc[16 * nt + r]; float e[4];
#pragma unroll
                    for (int g = 0; g < 4; ++g) { const int jj = 16 * mt + 4 * q + g, ii = 16 * nt + r; const bool keep = dir ? (jj >= ii) : (jj <= ii); e[g] = keep ? acc[m2][nt][g] * ex2(cgn - cgm[g]) : 0.f; }
                    pk[mt][nt][0] = cvt_pk_bf16(e[0], e[1]); pk[mt][nt][1] = cvt_pk_bf16(e[2], e[3]); } } }
        stage_copy(t0, lane, wsp<bf16_t>(p, WS_SSG) + un * 4096 + lane * 64);
        stage_copy(t1, lane, wsp<bf16_t>(p, WS_WNG) + un * 4096 + lane * 64);
        unsigned dl[4][4][2];
        {   const bf16_t* UT = wsp<bf16_t>(p, WS_UTG) + un * 4096;
#pragma unroll
            for (int mh = 0; mh < 2; ++mh) { f32x4 acc[2][4]; mm32<true>(acc, t1, t0, lane, mh);
#pragma unroll
                for (int m2 = 0; m2 < 2; ++m2)
#pragma unroll
                    for (int nt = 0; nt < 4; ++nt) { const int mt = 2 * mh + m2;
                        const pg::u32x2 uu = *(const pg::u32x2*)(UT + (16 * nt + r) * 64 + (dir ? 60 - 16 * mt - 4 * q : 16 * mt + 4 * q));
                        const float u0 = dir ? __uint_as_float(uu.y & 0xffff0000u) : __uint_as_float(uu.x << 16), u1 = dir ? __uint_as_float(uu.y << 16) : __uint_as_float(uu.x & 0xffff0000u),
                                    u2 = dir ? __uint_as_float(uu.x & 0xffff0000u) : __uint_as_float(uu.y << 16), u3 = dir ? __uint_as_float(uu.x << 16) : __uint_as_float(uu.y & 0xffff0000u);
                        dl[mt][nt][0] = cvt_pk_bf16(u0 - acc[m2][nt][0], u1 - acc[m2][nt][1]); dl[mt][nt][1] = cvt_pk_bf16(u2 - acc[m2][nt][2], u3 - acc[m2][nt][3]); } } }
        stage_copy(t1, lane, GQ + ((size_t)0 * T + row_l) * 256 + h * 64);
        f32x4 accO[4][4]; mm64<true>(accO, t0, t1, lane);
#pragma unroll
        for (int nt = 0; nt < 4; ++nt) { const float f = ex2(misc[16 * nt + r]);
#pragma unroll
            for (int mt = 0; mt < 4; ++mt) accO[mt][nt] *= f; }
#pragma unroll
        for (int mt = 0; mt < 4; ++mt)
#pragma unroll
            for (int nt = 0; nt < 4; ++nt) { u32x2 w; w.x = dl[mt][nt][0]; w.y = dl[mt][nt][1]; *(LAS u32x2*)(t1 + (16 * nt + r) * TS + (16 * mt + 4 * q) * 2) = w;
                                             u32x2 w2; w2.x = pk[mt][nt][0]; w2.y = pk[mt][nt][1]; *(LAS u32x2*)(t0 + (16 * nt + r) * TS + (16 * mt + 4 * q) * 2) = w2; }
        mm64(accO, t1, t0, lane);
        if (dir == 0) {
            float* pl = park + lane * 64;
#pragma unroll
            for (int mt = 0; mt < 4; ++mt)
#pragma unroll
                for (int nt = 0; nt < 4; ++nt) *(f32x4*)(pl + (mt * 4 + nt) * 4) = accO[mt][nt];
        } else {
            const float* pp = park + lane * 64; asm volatile("" : "+v"(pp) : "v"(accO[3][3][3]));
#pragma unroll
            for (int mt = 0; mt < 4; ++mt)
#pragma unroll
                for (int nt = 0; nt < 4; ++nt) accO[mt][nt] += *(const f32x4*)(pp + (mt * 4 + nt) * 4);
            head_out(p, p.inp(I_GNG) + l * 64, accO, nbase, ZC_GG + h * 64, 768 + h * 64, lane);
        }
    }
}
}

DEV void ph_x1(const PV& p, const int l, int bid, int nb, LAS unsigned char* lds3) {
    const int lane = TIDX & 63, wave = p.wv; LAS unsigned char* wl = lds3 + wave * mx::WAVE_LDS;
    for (int u = bid * 8 + wave; u < 16 * mx::NCH; u += nb * 8) { const int chain = (u / mx::NCH) & 7, s = u % mx::NCH; if (u < 8 * mx::NCH) mx::ret_x1(p, chain >> 2, chain & 3, s, wl, lane); else mx::hg_x1(p, l, chain >> 2, chain & 3, s, wl, lane); }
}
DEV void ph_x1_gdn(const PV& p, const int l, int bid, int nb, LAS unsigned char* lds3) {
    const int wave = p.wv; LAS unsigned char* wl = lds3 + wave * mx::WAVE_LDS;
    const int nw = nb * 8, tot = 8 * mx::NCH;
    if (nw == 2048) {
        int v = bid * 8 + wave; if (v >= 1554) v += 6; if (v >= 1807) v += 13;
        const int chain = v / mx::NCH, s = v % mx::NCH; if (chain >> 2) mx::gdn_x1<1>(p, l, chain & 3, s, wl, mx::relane()); else mx::gdn_x1<0>(p, l, chain & 3, s, wl, mx::relane());
        return;
    }
    for (int k = 0; k < 2; ++k) {
        int u = -1;
        if (k == 0) u = bid * 8 + wave; else if (wave == 7 && nw + bid < tot) u = nw + bid;
        if (u < 0 || u >= tot) continue;
        const int chain = u / mx::NCH, s = u % mx::NCH; if (chain >> 2) mx::gdn_x1<1>(p, l, chain & 3, s, wl, mx::relane()); else mx::gdn_x1<0>(p, l, chain & 3, s, wl, mx::relane());
    }
    for (int u = nw + nb + bid * 8 + wave; u < tot; u += nw) {
        const int chain = u / mx::NCH, s = u % mx::NCH; if (chain >> 2) mx::gdn_x1<1>(p, l, chain & 3, s, wl, mx::relane()); else mx::gdn_x1<0>(p, l, chain & 3, s, wl, mx::relane());
    }
}
DEV void ph_x1_gdn_deferred(const PV& p, const int l, int bid, int nb, LAS unsigned char* lds3) {
    const int wave = p.wv; LAS unsigned char* wl = lds3 + wave * mx::WAVE_LDS;
    if (nb * 8 != 2048 || bid >= 32 || wave != 1) return;
    const int v = bid < 6 ? 1554 + bid : (bid < 19 ? 1807 + (bid - 6) : 2067 + (bid - 19));
    const int chain = v / mx::NCH, s = v % mx::NCH; if (chain >> 2) mx::gdn_x1<1>(p, l, chain & 3, s, wl, mx::relane()); else mx::gdn_x1<0>(p, l, chain & 3, s, wl, mx::relane());
}
DEV void ph_x2(const PV& p, const int l, int bid, int nb) {
    const int t = TIDX; if (t >= 256) return;
    const int gt = bid * 256 + t;
    if (gt < 8 * 4096) mx::ret_x2(p, gt); else if (gt < 16 * 4096) mx::hg_x2(p, gt - 8 * 4096);
}
DEV void ph_gdn_l1(const PV& p, int bid, int nb, LAS unsigned char* lds3) { const int tid = TIDX, lane = tid & 63;
    for (int u = bid; u < 8 * mx::NGRP; u += nb) { if (u % mx::NGRP != mx::NGRP - 1) { mx::gdn_l1_lds(p, u / mx::NGRP, u % mx::NGRP, p.wv, lane, lds3, tid); __syncthreads(); } } }
DEV void ph_gdn_l2(const PV& p, int bid, int nb) { if (p.wv == 0 && bid < 32) mx::gdn_l2(p, bid >> 2, bid & 3, TIDX & 63); }
DEV void ph_gdn_l3(const PV& p, int bid, int nb) { const int lane = TIDX & 63; for (int u = p.wv * nb + bid; u < 8 * mx::NGRP * 4; u += nb * 8) mx::gdn_l3(p, u / (mx::NGRP * 4), (u >> 2) % mx::NGRP, u & 3, lane); }
DEV void ph_x3_ret(const PV& p, const int l, int bid, int nb, LAS unsigned char* lds3, const int u0, const int u1, const int gw0, const int b0) {
    const int lane = TIDX & 63, wave = p.wv; LAS unsigned char* wl = lds3 + wave * mx::WAVE_LDS;
    if (b0 == -4) {
        int u = -1;
        if (wave >= 5) u = u0 + (wave - 5) * nb + bid; else if (wave == 4 && bid >= 16) u = u0 + 3 * nb + (bid - 16);
        if (u >= 0 && u < u1) mx::ret_x3(p, l, u / mx::NCH, u % mx::NCH, wl, lane);
        return; }
    if (b0 == -2) { for (int u = u0 + wave * nb + bid; u < u1; u += nb * 8) mx::ret_x3(p, l, u / mx::NCH, u % mx::NCH, wl, lane); return; }
    if (b0 < 0) { const int nw = nb * 8; int k = bid * 8 + wave - gw0; if (k < 0) k += nw;
        for (int u = u0 + k; u < u1; u += nw) mx::ret_x3(p, l, u / mx::NCH, u % mx::NCH, wl, lane); return; }
    if (bid < b0) return;
    const int nw = (nb - b0) * 8; const int k = wave * (nb - b0) + (bid - b0) - gw0; if (k < 0) return;
    for (int u = u0 + k; u < u1; u += nw) mx::ret_x3(p, l, u / mx::NCH, u % mx::NCH, wl, lane);
}
DEV void ph_x3_gdn(const PV& p, const int l, int bid, int nb, LAS unsigned char* lds3) {
    const int lane = TIDX & 63, wave = p.wv; LAS unsigned char* wl = lds3 + wave * mx::WAVE_LDS;
    float* park = wsp<float>(p, mx::WS_PARK) + (size_t)(bid * 8 + wave) * 4096;
    for (int u = wave * nb + bid; u < 4 * mx::NCH; u += nb * 8) mx::gdn_x3(p, l, u / mx::NCH, u % mx::NCH, wl, lane, park);
}
DEV void ph_x3_hg(const PV& p, const int l, int bid, int nb, LAS unsigned char* lds3, const int u0, const int u1, const int gw0, const int b0) {
    const int lane = TIDX & 63, wave = p.wv; LAS unsigned char* wl = lds3 + wave * mx::WAVE_LDS;
    float* park = wsp<float>(p, mx::WS_PARK2) + (size_t)(bid * 8 + wave) * 4096;
    if (bid < b0) return;
    const int nw = (nb - b0) * 8; const int k = wave * (nb - b0) + (bid - b0) - gw0; if (k < 0) return;
    for (int u = u0 + k; u < u1; u += nw) mx::hg_x3(p, l, u / mx::NCH, u % mx::NCH, wl, lane, park);
}

DEV void ph_topk_fast(const PV& p, const int l, int bid, int nb, LAS unsigned char* lds3) {
    const float* AFF = wsp<float>(p, WS_AFF); int* INV = wsp<int>(p, WS_INV); int* IDX = wsp<int>(p, WS_IDX); float* VAL = wsp<float>(p, WS_VAL);
    const int tid = TIDX, lane = tid & 63, wave = p.wv;
    LAS unsigned* hist = (LAS unsigned*)lds3;
    LAS unsigned* ctl = hist + 256;
    LAS unsigned* cnt = hist + 320;
    const int nunits = l == 0 ? 2 * NE : NE;
    for (int u = bid; u < nunits; u += nb) {
        const bool isctx = u >= NE; const int e = isctx ? u - NE : u;
        const int n = isctx ? NC : NL, cap = isctx ? CAP_C : CAP_L, rowbase = isctx ? 0 : NC, soff = isctx ? CAP_L : 0;
        const int tpt = isctx ? 1 : 32, t0 = tid * tpt; const bool act = t0 < n;
        unsigned v[32];
#pragma unroll
        for (int k = 0; k < 32; ++k) v[k] = (act && k < tpt) ? __float_as_uint(AFF[(size_t)(rowbase + t0 + k) * 16 + e]) : 0u;
        unsigned prefix = 0u, kth = (unsigned)cap;
#pragma unroll 1
        for (int shift = 24; shift >= 0; shift -= 8) {
            if (tid < 256) hist[tid] = 0u;
            __syncthreads();
            const unsigned himask = shift == 24 ? 0u : (0xffffffffu << (shift + 8));
#pragma unroll
            for (int k = 0; k < 32; ++k) if (act && k < tpt && (v[k] & himask) == prefix) __hip_atomic_fetch_add(&hist[(v[k] >> shift) & 255u], 1u, __ATOMIC_RELAXED, __HIP_MEMORY_SCOPE_WORKGROUP);
            __syncthreads();
            if (wave == 0) {
                const int g = 15 - (lane & 15); unsigned h[16], tot = 0u;
#pragma unroll
                for (int j = 0; j < 16; ++j) { h[j] = hist[16 * g + 15 - j]; tot += h[j]; }
                unsigned pre = 0u, run = tot;
                { unsigned t = USWZ(run, 0x041F); pre += (lane & 1) ? t : 0u; run += t; t = USWZ(run, 0x081F); pre += (lane & 2) ? t : 0u; run += t;
                  t = USWZ(run, 0x101F); pre += (lane & 4) ? t : 0u; run += t; t = USWZ(run, 0x201F); pre += (lane & 8) ? t : 0u; run += t; }
                unsigned cum = pre, bsel = 0u, rsel = 0u; bool found = !(pre < kth && kth <= pre + tot);
#pragma unroll
                for (int j = 0; j < 16; ++j) { const bool f = !found && cum + h[j] >= kth; bsel = f ? (unsigned)(16 * g + 15 - j) : bsel; rsel = f ? kth - cum : rsel; found = found || f; cum += found ? 0u : h[j]; }
                if (lane < 16 && pre < kth && kth <= pre + tot) { ctl[0] = bsel; ctl[1] = rsel; }
            }
            __syncthreads();
            prefix |= ctl[0] << shift; kth = ctl[1];
            __syncthreads();
        }
        const unsigned thr = prefix, need_eq = kth;
        unsigned cgt = 0u, ceq = 0u;
#pragma unroll
        for (int k = 0; k < 32; ++k) if (act && k < tpt) { cgt += v[k] > thr ? 1u : 0u; ceq += v[k] == thr ? 1u : 0u; }
        unsigned before = 0u;
        { unsigned run = cgt | (ceq << 16), t;
          t = USWZ(run, 0x041F); before += (lane & 1) ? t : 0u; run += t; t = USWZ(run, 0x081F); before += (lane & 2) ? t : 0u; run += t;
          t = USWZ(run, 0x101F); before += (lane & 4) ? t : 0u; run += t; t = USWZ(run, 0x201F); before += (lane & 8) ? t : 0u; run += t;
          t = USWZ(run, 0x401F); before += (lane & 16) ? t : 0u; run += t;
          const auto rr = __builtin_amdgcn_permlane32_swap(run, run, false, false); t = rr[0] + rr[1] - run; before += (lane & 32) ? t : 0u; run += t;
          if (lane == 63) cnt[512 + wave] = run; }
        __syncthreads();
        for (int w = 0; w < wave; ++w) before += cnt[512 + w];
        unsigned gtb = before & 0xffffu, eqb = before >> 16;
#pragma unroll
        for (int k = 0; k < 32; ++k) if (act && k < tpt) {
            const bool gt = v[k] > thr, eq = v[k] == thr; const bool sel = gt || (eq && eqb < need_eq);
            const int slot = soff + (int)(gtb + (eqb < need_eq ? eqb : need_eq)); const int row = rowbase + t0 + k;
            INV[(size_t)row * 16 + e] = sel ? slot : -1;
            if (sel) { IDX[e * EROWS + slot] = row; VAL[e * EROWS + slot] = __uint_as_float(v[k]); }
            gtb += gt ? 1u : 0u; eqb += eq ? 1u : 0u;
        }
        __syncthreads();
    }
    for (int idx = bid * NTHREADS_C + tid; idx < NE * (EROWS - CAP_L); idx += nb * NTHREADS_C) { const int e = idx / (EROWS - CAP_L), sl = CAP_L + idx % (EROWS - CAP_L);
        if (l != 0 || sl >= CAP_L + CAP_C) { IDX[e * EROWS + sl] = 0; VAL[e * EROWS + sl] = 0.f; } }
}

#define XB_TMO      128
#define XB_XCNT(j)  (256  + 64 * (j))
#define XB_XSUB(j)  (1280 + 64 * (j))
#define XB_XGEN(j)  (2304 + 64 * (j))
#define XB_TOP      3328
#define XB_TOPGEN   3392
#define XCD_BAR_WORDS 3456
#define XB_SPIN_CAP (1u << 18)

__device__ __forceinline__ unsigned xb_ld(unsigned* p)              { return __hip_atomic_load(p, __ATOMIC_RELAXED, __HIP_MEMORY_SCOPE_AGENT); }
__device__ __forceinline__ unsigned xb_add(unsigned* p, unsigned v) { return __hip_atomic_fetch_add(p, v, __ATOMIC_RELAXED, __HIP_MEMORY_SCOPE_AGENT); }
__device__ __forceinline__ unsigned xb_xcc_id() { return (unsigned)__builtin_amdgcn_s_getreg((3 << 11) | 20) & 0xFu; }
#define XB_SPIN(cond, bar) do { unsigned _sp = 0; while (cond) { __builtin_amdgcn_s_sleep(1); \
    if ((++_sp & 255u) == 0u) { if (xb_ld(&(bar)[XB_TMO])) break; if (_sp > XB_SPIN_CAP) { atomicAdd(&(bar)[XB_TMO], 1u); break; } } } } while (0)

struct XcdBarrier {
    unsigned* bar; unsigned x;
    volatile __attribute__((address_space(3))) unsigned* st;
};

__device__ __forceinline__ XcdBarrier xcd_barrier_post(unsigned* bar, volatile __attribute__((address_space(3))) unsigned* st) {
    XcdBarrier b; b.bar = bar; b.x = xb_xcc_id(); b.st = st;
    if (threadIdx.x == 0) (void)xb_add(&bar[XB_XCNT(b.x)], 1u);
    return b;
}
__device__ __forceinline__ void xcd_barrier_complete(unsigned* bar, unsigned x, unsigned& nloc, unsigned& nx) {
    const unsigned G = gridDim.x * gridDim.y * gridDim.z;
    unsigned sum, cnt, mine, sp = 0u;
    for (;;) {
        sum = 0u; cnt = 0u; mine = 0u;
#pragma unroll
        for (unsigned j = 0; j < 16; ++j) { const unsigned c = xb_ld(&bar[XB_XCNT(j)]); sum += c; cnt += (c > 0u) ? 1u : 0u; mine = (j == x) ? c : mine; }
        if (sum == G) break;
        __builtin_amdgcn_s_sleep(1);
        if ((++sp & 255u) == 0u) { if (xb_ld(&bar[XB_TMO])) break; if (sp > XB_SPIN_CAP) { atomicAdd(&bar[XB_TMO], 1u); break; } }
    }
    nloc = mine > 0u ? mine : 1u; nx = cnt > 0u ? cnt : 1u;
}

__device__ __forceinline__ void xcd_barrier(const XcdBarrier& b) {
    asm volatile("s_waitcnt vmcnt(0)" ::: "memory");
    __syncthreads();
    if (threadIdx.x == 0) {
        unsigned* bar = b.bar;
        __builtin_amdgcn_s_waitcnt(0);
        unsigned nloc = b.st[0], nx = b.st[1];
        if (nloc == 0u) { xcd_barrier_complete(bar, b.x, nloc, nx); b.st[0] = nloc; b.st[1] = nx; }
        const unsigned old = xb_add(&bar[XB_XSUB(b.x)], 1u);
        const unsigned gen = old / nloc;
        if (old + 1u == (gen + 1u) * nloc) {
            __builtin_amdgcn_fence(__ATOMIC_RELEASE, "agent");
            asm volatile("s_waitcnt vmcnt(0)" ::: "memory");
            const unsigned og = xb_add(&bar[XB_TOP], 1u);
            const unsigned tg = og / nx;
            if (og + 1u == (tg + 1u) * nx) xb_add(&bar[XB_TOPGEN], 1u);
            else XB_SPIN(xb_ld(&bar[XB_TOPGEN]) == tg, bar);
            __builtin_amdgcn_fence(__ATOMIC_ACQUIRE, "agent");
            xb_add(&bar[XB_XGEN(b.x)], 1u);
            asm volatile("s_waitcnt vmcnt(0)" ::: "memory");
        } else {
            XB_SPIN(xb_ld(&bar[XB_XGEN(b.x)]) == gen, bar);
            __builtin_amdgcn_fence(__ATOMIC_ACQUIRE, "agent");
            asm volatile("s_waitcnt vmcnt(0)" ::: "memory");
        }
    }
    __syncthreads();
}


DEV unsigned opaque_zero() { unsigned z; asm volatile("s_mov_b32 %0, 0" : "=s"(z)); return z; }
DEV void xbar_sync(const XcdBarrier& b) { XcdBarrier c = b; const unsigned z = opaque_zero(); c.bar = b.bar + z; c.x = b.x + z; xcd_barrier(c); }
constexpr int NTHREADS = 512;
constexpr int LDS_MIX = 8 * 19456, LDS_BYTES = LDS_MIX + 64;
__global__ void __launch_bounds__(NTHREADS) mega_fwd(P p) {
    extern __shared__ __attribute__((aligned(16))) unsigned char smem[];
    LAS unsigned char* lds3 = (LAS unsigned char*)smem;
    const int wv_ = __builtin_amdgcn_readfirstlane((int)(threadIdx.x >> 6));
    if (threadIdx.x < 16) ((LAS unsigned*)(lds3 + LDS_MIX))[threadIdx.x] = 0u;
    __syncthreads();
    const XcdBarrier xbar = xcd_barrier_post((unsigned*)p.ws, (volatile LAS unsigned*)(lds3 + LDS_MIX));
        { const PV q{p, opaque_zero(), wv_}; const int bid = blockIdx.x + q.z, nb = gridDim.x + q.z; ph_prologue(q, 0, bid, nb, lds3); }
    xbar_sync(xbar);
    for (int l = 0; l < 2; ++l) {
        if (l == 0) {
        { const PV q{p, opaque_zero(), wv_}; const int bid = blockIdx.x + q.z, nb = gridDim.x + q.z; ph_rows0(q, 0, bid, nb, lds3); }
        __syncthreads();
        { const PV q{p, opaque_zero(), wv_}; const int bid = blockIdx.x + q.z, nb = gridDim.x + q.z; ph_wconv(q, 0, bid, nb, lds3, 0); }            xbar_sync(xbar);
        }
        { const PV q{p, opaque_zero(), wv_}; const int bid = blockIdx.x + q.z, nb = gridDim.x + q.z; ph_g1_fast(q, bid, nb, lds3); }          xbar_sync(xbar);
        { const PV q{p, opaque_zero(), wv_}; const int bid = blockIdx.x + q.z, nb = gridDim.x + q.z; ph_mixprep(q, l, bid, nb); }
        { const PV q{p, opaque_zero(), wv_}; const int bid = blockIdx.x + q.z, nb = gridDim.x + q.z; ph_x1(q, l, bid, nb, lds3); }          xbar_sync(xbar);
        { const PV q{p, opaque_zero(), wv_}; const int bid = blockIdx.x + q.z, nb = gridDim.x + q.z; ph_x1_gdn(q, l, bid, nb, lds3); }
        { const PV q{p, opaque_zero(), wv_}; const int bid = blockIdx.x + q.z, nb = gridDim.x + q.z; ph_x2(q, l, bid, nb); }          xbar_sync(xbar);
        { const PV q{p, opaque_zero(), wv_}; const int bid = blockIdx.x + q.z, nb = gridDim.x + q.z; ph_gdn_l1(q, bid, nb, lds3); }
        xbar_sync(xbar);
        { const PV q{p, opaque_zero(), wv_}; const int bid = blockIdx.x + q.z, nb = gridDim.x + q.z; ph_gdn_l2(q, bid, nb); }
        { const PV q{p, opaque_zero(), wv_}; const int bid = blockIdx.x + q.z, nb = gridDim.x + q.z; ph_x1_gdn_deferred(q, l, bid, nb, lds3); }
        { const PV q{p, opaque_zero(), wv_}; const int bid = blockIdx.x + q.z, nb = gridDim.x + q.z; ph_x3_ret(q, l, bid, nb, lds3, 4 * mx::NCH - 32, 4 * mx::NCH, 4 * mx::NCH, 32); }
        { const PV q{p, opaque_zero(), wv_}; const int bid = blockIdx.x + q.z, nb = gridDim.x + q.z; ph_x3_hg(q, l, bid, nb, lds3, 0, 4 * mx::NCH, 0, 32); }          xbar_sync(xbar);
        { const PV q{p, opaque_zero(), wv_}; const int bid = blockIdx.x + q.z, nb = gridDim.x + q.z; ph_gdn_l3(q, bid, nb); }
        __syncthreads();
        { const PV q{p, opaque_zero(), wv_}; const int bid = blockIdx.x + q.z, nb = gridDim.x + q.z; ph_attn_fast(q, l, bid, nb, smem); }  xbar_sync(xbar);
        { const PV q{p, opaque_zero(), wv_}; const int bid = blockIdx.x + q.z, nb = gridDim.x + q.z; ph_x3_gdn(q, l, bid, nb, lds3); }
        { const PV q{p, opaque_zero(), wv_}; const int bid = blockIdx.x + q.z, nb = gridDim.x + q.z; ph_x3_ret(q, l, bid, nb, lds3, 0, 4 * mx::NCH - 32, 0, -4); }         xbar_sync(xbar);
        { const PV q{p, opaque_zero(), wv_}; const int bid = blockIdx.x + q.z, nb = gridDim.x + q.z; ph_g2_fast(q, l, bid, nb, lds3); }          xbar_sync(xbar);
        { const PV q{p, opaque_zero(), wv_}; const int bid = blockIdx.x + q.z, nb = gridDim.x + q.z; ph_g3_fast(q, l, bid, nb, lds3); }          xbar_sync(xbar);
        { const PV q{p, opaque_zero(), wv_}; const int bid = blockIdx.x + q.z, nb = gridDim.x + q.z; ph_g4_fast(q, l, bid, nb, lds3); }          xbar_sync(xbar);
        { const PV q{p, opaque_zero(), wv_}; const int bid = blockIdx.x + q.z, nb = gridDim.x + q.z; ph_rows1(q, l, bid, nb, lds3); }            xbar_sync(xbar);
        { const PV q{p, opaque_zero(), wv_}; const int bid = blockIdx.x + q.z, nb = gridDim.x + q.z; ph_topk_fast(q, l, bid, nb, lds3); }
        __syncthreads();
        { const PV q{p, opaque_zero(), wv_}; const int bid = blockIdx.x + q.z, nb = gridDim.x + q.z; ph_wconv(q, l, bid, nb, lds3, 1); }  xbar_sync(xbar);
        { const PV q{p, opaque_zero(), wv_}; const int bid = blockIdx.x + q.z, nb = gridDim.x + q.z; ph_g5_fast(q, l, bid, nb, lds3); }     xbar_sync(xbar);
        { const PV q{p, opaque_zero(), wv_}; const int bid = blockIdx.x + q.z, nb = gridDim.x + q.z; ph_g6_fast(q, l, bid, nb, lds3); }    xbar_sync(xbar);
        { const PV q{p, opaque_zero(), wv_}; const int bid = blockIdx.x + q.z, nb = gridDim.x + q.z; ph_rows2(q, l, bid, nb, lds3); }
        if (l == 0) {
        __syncthreads();
        { const PV q{p, opaque_zero(), wv_}; const int bid = blockIdx.x + q.z, nb = gridDim.x + q.z; ph_wconv(q, 1, bid, nb, lds3, 0); }            xbar_sync(xbar);
        }
    }
}

extern "C" void kernel_launch(void* const* d_in, const int* in_sizes, int n_in, void* d_out, int out_size, void* d_ws, size_t ws_size, hipStream_t stream) {
    if (n_in != N_IN || ws_size < WS_END || out_size != NL * D) { fprintf(stderr, "kernel_launch: unexpected sizes n_in %d ws %zu out %d\n", n_in, ws_size, out_size); return; }
    static int grid_blocks = 0;
    if (!grid_blocks) {
        int dev = 0, cus = 0, per_cu = 0;
        (void)hipGetDevice(&dev);
        (void)hipDeviceGetAttribute(&cus, hipDeviceAttributeMultiprocessorCount, dev);
        (void)hipFuncSetAttribute((const void*)mega_fwd, hipFuncAttributeMaxDynamicSharedMemorySize, LDS_BYTES);
        (void)hipOccupancyMaxActiveBlocksPerMultiprocessor(&per_cu, (const void*)mega_fwd, NTHREADS, LDS_BYTES);
        if (per_cu < 1) { fprintf(stderr, "kernel_launch: occupancy query says %d blocks/CU\n", per_cu); per_cu = 1; }
        if (per_cu > 1) per_cu = 1;
        grid_blocks = cus * per_cu;
    }
    (void)hipMemsetAsync(d_ws, 0, 65536, stream);
    P p{};
    for (int i = 0; i < N_IN; ++i) p.in[i] = (const float*)d_in[i];
    p.out = (float*)d_out; p.ws = (unsigned char*)d_ws;
    void* args[] = {&p};
    hipError_t e = hipLaunchCooperativeKernel((const void*)mega_fwd, dim3(grid_blocks), dim3(NTHREADS), args, LDS_BYTES, stream);
    if (e != hipSuccess) fprintf(stderr, "cooperative launch failed: %s (grid %d)\n", hipGetErrorString(e), grid_blocks);
}
```

```cpp
#include <hip/hip_runtime.h>
#include <hip/hip_cooperative_groups.h>
#include <cstdio>
#include <cstdint>

namespace cg = cooperative_groups;
#define DEV __device__ __forceinline__
#define LAS __attribute__((address_space(3)))
typedef unsigned short bf16_t;
typedef float f32x4 __attribute__((ext_vector_type(4)));

constexpr int NC = 256, NL = 16384, T = NC + NL, D = 1024, DIN = 3856, ZW = 3840, GW = 64;
constexpr int NE = 16, CAP_L = 2048, CAP_C = 32, EROWS = 2304;
constexpr float EPS = 1e-6f;
constexpr float C2 = 0.125f * 1.4426950408889634f;
constexpr int ZC_RQ = 0, ZC_RK = 256, ZC_RV = 512, ZC_RG = 768, ZC_HQ = 1024, ZC_HFF = 1280, ZC_HFB = 1536, ZC_HI = 1792, ZC_HG = 2048,
              ZC_AQ = 2304, ZC_AK = 2560, ZC_AV = 2688, ZC_GQ = 2816, ZC_GK = 3072, ZC_GV = 3328, ZC_GG = 3584;
enum { I_X = 0, I_C, I_CTX, I_CCTX, I_WADA, I_BADA, I_GPM, I_GPOM, I_GPF, I_GPOF, I_WIN, I_RNG, I_LBL, I_HNG, I_AQG, I_AKG, I_CONV, I_ALOG, I_DTB, I_GNG,
       I_WBR, I_WMG, I_WOUT, I_WRT, I_WEG, I_WEU, I_WED, N_IN };

constexpr size_t MiB = 1u << 20;
constexpr size_t WS_MOD = 1 * MiB;
constexpr size_t WS_LB = WS_MOD + 128 * 1024;
constexpr size_t WS_ROPE = WS_LB + 8 * 1024;
constexpr size_t WS_GATE = 2 * MiB;
constexpr size_t WS_AFF = 4 * MiB;
constexpr size_t WS_INV = 6 * MiB;
constexpr size_t WS_IDX = 8 * MiB;
constexpr size_t WS_VAL = WS_IDX + 256 * 1024;
constexpr size_t WS_XC = 16 * MiB;
constexpr size_t WS_H = 81 * MiB;
constexpr size_t WS_Y = 114 * MiB;
constexpr size_t WS_M = 147 * MiB;
constexpr size_t WS_YO = 180 * MiB;
constexpr size_t WS_Z = 245 * MiB;
constexpr size_t WS_XE = 245 * MiB;
constexpr size_t WS_YE = 317 * MiB;
constexpr size_t WS_ACT = 114 * MiB;
constexpr size_t WS_GQKV = 147 * MiB;
constexpr size_t WS_AQ = 172 * MiB;
constexpr size_t WS_AK = 181 * MiB;
constexpr size_t WS_AV = 186 * MiB;
constexpr size_t WS_END = 555 * MiB;

struct P {
    const float* in[N_IN];
    float* out;
    unsigned char* ws;
    int pad0, pad1;
};

DEV float bf2f(bf16_t v) { return __uint_as_float(((unsigned)v) << 16); }
DEV bf16_t f2bf(float f) { unsigned u = __float_as_uint(f); u += 0x7fffu + ((u >> 16) & 1u); return (bf16_t)(u >> 16); }
DEV float sigm(float x) { return 1.f / (1.f + expf(-x)); }
DEV float silu(float x) { return x / (1.f + expf(-x)); }
DEV float pg_fsigm(float x) { return __builtin_amdgcn_rcpf(1.f + __builtin_amdgcn_exp2f(-1.4426950408889634f * x)); }
#define RL(x, d) __int_as_float(__builtin_amdgcn_readlane(__float_as_int(x), (d)))
#define SWZ_XOR(v, pat) __int_as_float(__builtin_amdgcn_ds_swizzle(__float_as_int(v), (pat)))
#define USWZ(v, pat) ((unsigned)__builtin_amdgcn_ds_swizzle((int)(v), (pat)))
DEV float wave_sum(float v) {
    v += SWZ_XOR(v, 0x041F); v += SWZ_XOR(v, 0x081F); v += SWZ_XOR(v, 0x101F); v += SWZ_XOR(v, 0x201F); v += SWZ_XOR(v, 0x401F);
    const auto rr = __builtin_amdgcn_permlane32_swap(__float_as_uint(v), __float_as_uint(v), false, false);
    return __uint_as_float(rr[0]) + __uint_as_float(rr[1]);
}
struct PV {
    const P& a; unsigned z; int wv;
    DEV int tid() const { return wv * 64 + (int)__builtin_amdgcn_mbcnt_hi(~0u, __builtin_amdgcn_mbcnt_lo(~0u, z)); }
    DEV const float* inp(int i) const { return (const float*)((const char*)a.in[i] + z); }
    DEV float* outp() const { return (float*)((char*)a.out + z); }
    DEV unsigned char* wsb() const { return a.ws + z; }
};
template <class Tp> DEV Tp* wsp(const PV& p, size_t off) { return (Tp*)(p.wsb() + off); }

#define TIDX (p.tid())
constexpr int NTHREADS_C = 512;
DEV void ph_prologue(const PV& p, const int l, int bid, int nb, LAS unsigned char* lds3) {
    const int gt = bid * blockDim.x + TIDX, ng = nb * blockDim.x;
    {
        float* MOD = wsp<float>(p, WS_MOD); LAS float* sl = (LAS float*)lds3; LAS float* red = sl + 2048;
        const int tid = TIDX, lane = tid & 63, wave = p.wv;
        for (int i = tid; i < 2048; i += NTHREADS_C) { const float x = (i < 1024 ? p.inp(I_CCTX) : p.inp(I_C))[i & 1023]; sl[i] = silu(x); }
        __syncthreads();
        for (int it = bid; it < 2 * 96; it += nb) { const int l = it / 96, j = (it % 96) * 64 + lane;
            const float* wa = p.inp(I_WADA) + ((size_t)l * 1024 + wave * 128) * 6144 + j;
            float a0 = 0.f, a1 = 0.f;
#pragma unroll 16
            for (int k = 0; k < 128; ++k) { const float w = wa[(size_t)k * 6144]; a0 += sl[wave * 128 + k] * w; a1 += sl[1024 + wave * 128 + k] * w; }
            red[(wave * 2 + 0) * 64 + lane] = a0; red[(wave * 2 + 1) * 64 + lane] = a1;
            __syncthreads();
            if (wave < 2) { float t = p.inp(I_BADA)[l * 6144 + j];
#pragma unroll
                for (int w8 = 0; w8 < 8; ++w8) t += red[(w8 * 2 + wave) * 64 + lane];
                MOD[(l * 2 + wave) * 6144 + j] = t; }
            __syncthreads();
        }
    }
    float* LB = wsp<float>(p, WS_LB);
    for (int idx = gt; idx < 2 * 2 * 256; idx += ng) {
        const int dir = idx / 512, l = (idx / 256) & 1, i = idx % 256;
        const float l0 = p.inp(I_LBL)[(dir * 2 + 0) * 256 + i], l1 = p.inp(I_LBL)[(dir * 2 + 1) * 256 + i];
        LB[idx] = l ? 1.f / (1.f + expf(l0 - l1)) : 0.f;
    }
    float* RC = wsp<float>(p, WS_ROPE);
    for (int idx = gt; idx < 256 * 16; idx += ng) {
        const int pos = idx / 16, j = idx % 16;
        const double inv = pow(10000.0, -(double)j / 16.0), a = (double)pos * inv;
        RC[idx] = (float)cos(a); RC[4096 + idx] = (float)sin(a);
    }
}

DEV void stage_table16(LAS float* tab, const float* src, const size_t ld, const int tid) {
    for (int i = tid; i < 4096; i += NTHREADS_C) { const int k = i >> 2, q = i & 3, j = k >> 8, L = (k >> 2) & 63, e = k & 3;
        *(LAS f32x4*)(tab + ((j * 4 + e) * 64 + L) * 20 + q * 4) = *(const f32x4*)(src + (size_t)k * ld + q * 4); }
    __syncthreads();
}
DEV void dot16(float (&acc)[16], const f32x4 (&h)[4], LAS const float* tab, const int lane) {
#pragma unroll
    for (int j = 0; j < 4; ++j)
#pragma unroll
        for (int e = 0; e < 4; ++e) { const float he = h[j][e]; LAS const float* t = tab + ((j * 4 + e) * 64 + lane) * 20;
#pragma unroll
            for (int q = 0; q < 4; ++q) { const f32x4 w = *(LAS const f32x4*)(t + q * 4); acc[q * 4 + 0] += he * w.x; acc[q * 4 + 1] += he * w.y; acc[q * 4 + 2] += he * w.z; acc[q * 4 + 3] += he * w.w; }
            if (e & 1) __builtin_amdgcn_sched_barrier(0);
        }
}
DEV int idx16(const int lane) { return ((lane >> 4) & 1) * 8 + ((lane >> 3) & 1) * 4 + ((lane >> 2) & 1) * 2 + ((lane >> 1) & 1); }
DEV float selm(const unsigned m, const float a, const float b) { return __uint_as_float((__float_as_uint(a) & m) | (__float_as_uint(b) & ~m)); }
DEV float reduce16(const float (&v)[16], const int lane) {
    const unsigned m4 = 0u - ((lane >> 4) & 1), m3 = 0u - ((lane >> 3) & 1), m2 = 0u - ((lane >> 2) & 1), m1 = 0u - ((lane >> 1) & 1);
    float a[8], b[4], c[2];
#pragma unroll
    for (int i = 0; i < 8; ++i) a[i] = selm(m4, v[i + 8], v[i]) + SWZ_XOR(selm(m4, v[i], v[i + 8]), 0x401F);
#pragma unroll
    for (int i = 0; i < 4; ++i) b[i] = selm(m3, a[i + 4], a[i]) + SWZ_XOR(selm(m3, a[i], a[i + 4]), 0x201F);
#pragma unroll
    for (int i = 0; i < 2; ++i) c[i] = selm(m2, b[i + 2], b[i]) + SWZ_XOR(selm(m2, b[i], b[i + 2]), 0x101F);
    float d = selm(m1, c[1], c[0]) + SWZ_XOR(selm(m1, c[0], c[1]), 0x081F);
    d += SWZ_XOR(d, 0x041F);
    const auto rr = __builtin_amdgcn_permlane32_swap(__float_as_uint(d), __float_as_uint(d), false, false);
    return __uint_as_float(rr[0]) + __uint_as_float(rr[1]);
}
DEV float max16(float v) { v = fmaxf(v, SWZ_XOR(v, 0x081F)); v = fmaxf(v, SWZ_XOR(v, 0x101F)); v = fmaxf(v, SWZ_XOR(v, 0x201F)); v = fmaxf(v, SWZ_XOR(v, 0x401F)); return v; }
DEV float sum16(float v) { v += SWZ_XOR(v, 0x081F); v += SWZ_XOR(v, 0x101F); v += SWZ_XOR(v, 0x201F); v += SWZ_XOR(v, 0x401F); return v; }
DEV float dot4(const f32x4 v) { return v.x * v.x + v.y * v.y + v.z * v.z + v.w * v.w; }
DEV uint2 pack4(const f32x4 h) { return make_uint2((unsigned)f2bf(h.x) | ((unsigned)f2bf(h.y) << 16), (unsigned)f2bf(h.z) | ((unsigned)f2bf(h.w) << 16)); }

DEV void rows0_core(const PV& p, const int r, const int lane, const f32x4 (&x)[4], const f32x4 (&gs)[4], const f32x4 (&sh)[4], LAS const float* tab) {
    bf16_t* H = wsp<bf16_t>(p, WS_H); float* GATE = wsp<float>(p, WS_GATE);
    float ss = 0.f;
#pragma unroll
    for (int j = 0; j < 4; ++j) ss += dot4(x[j]);
    const float rstd = rsqrtf(wave_sum(ss) * (1.f / 1024.f) + EPS);
    f32x4 h[4];
#pragma unroll
    for (int j = 0; j < 4; ++j) { h[j] = x[j] * rstd * gs[j] + sh[j]; *(uint2*)(H + (size_t)r * 1024 + j * 256 + lane * 4) = pack4(h[j]); }
    float ga[16];
#pragma unroll
    for (int i = 0; i < 16; ++i) ga[i] = 0.f;
    dot16(ga, h, tab, lane);
    const float s = reduce16(ga, lane);
    if ((lane & 33) == 0) GATE[(size_t)r * 16 + idx16(lane)] = s;
}
DEV void ph_rows0(const PV& p, const int l, int bid, int nb, LAS unsigned char* lds3) {
    const int tid = TIDX, lane = tid & 63, wpb = blockDim.x >> 6;
    const int gw = bid * wpb + p.wv, ngw = nb * wpb;
    LAS float* tab = (LAS float*)lds3;
    stage_table16(tab, p.inp(I_WIN) + (size_t)l * 1024 * DIN + 3584, DIN, tid);
    const float* g = p.inp(I_GPM) + l * 1024;
#pragma unroll 1
    for (int seg = 0; seg < 2; ++seg) {
        const float* mod = wsp<float>(p, WS_MOD) + (l * 2 + seg) * 6144;
        const float* XI = l ? wsp<float>(p, WS_XC) : (seg ? p.inp(I_X) - (size_t)NC * 1024 : p.inp(I_CTX));
        f32x4 gs[4], sh[4];
#pragma unroll
        for (int j = 0; j < 4; ++j) { const int k0 = j * 256 + lane * 4; gs[j] = *(const f32x4*)(g + k0) * (1.f + *(const f32x4*)(mod + 1024 + k0)); sh[j] = *(const f32x4*)(mod + k0); }
        const int r0 = seg ? NC + gw : gw, rend = seg ? T : NC;
        f32x4 xn[4];
        if (r0 < rend) {
#pragma unroll
            for (int j = 0; j < 4; ++j) xn[j] = *(const f32x4*)(XI + (size_t)r0 * 1024 + j * 256 + lane * 4);
        }
        for (int r = r0; r < rend; r += ngw) {
            f32x4 x[4];
#pragma unroll
            for (int j = 0; j < 4; ++j) x[j] = xn[j];
            const int rn = r + ngw;
            if (rn < rend) {
#pragma unroll
                for (int j = 0; j < 4; ++j) xn[j] = *(const f32x4*)(XI + (size_t)rn * 1024 + j * 256 + lane * 4);
            }
            rows0_core(p, r, lane, x, gs, sh, tab);
        }
    }
}

typedef unsigned u32x4_t __attribute__((ext_vector_type(4)));
DEV void ph_mixprep(const PV& p, const int l, int bid, int nb) {
    const int tid = TIDX, lane = tid & 63, sub = lane & 7, tsk = lane >> 3;
    const bf16_t* Z = wsp<bf16_t>(p, WS_Z); const float* RC = wsp<float>(p, WS_ROPE);
    bf16_t* AQ = wsp<bf16_t>(p, WS_AQ); bf16_t* AK = wsp<bf16_t>(p, WS_AK); bf16_t* AV = wsp<bf16_t>(p, WS_AV); bf16_t* GQKV = wsp<bf16_t>(p, WS_GQKV);
    const int gw = bid * 8 + p.wv - 64, ngw = nb * 8 - 64;
    if (gw < 0) return;
    {
        const bool isq = tsk < 4, isn = tsk < 6, hi = (sub & 2) != 0;
        const int zc = (isq ? ZC_AQ + tsk * 64 : (isn ? ZC_AK + (tsk - 4) * 64 : ZC_AV + (tsk - 6) * 64)) + sub * 8;
        const float* gp = (isq ? p.inp(I_AQG) : p.inp(I_AKG)) + l * 64 + sub * 8;
        float g[8];
#pragma unroll
        for (int e = 0; e < 8; ++e) g[e] = isn ? gp[e] * (isq ? C2 : 1.f) : 1.f;
        bf16_t* dbase = isq ? AQ + tsk * 64 + sub * 8 : (isn ? AK + (tsk - 4) * 64 + sub * 8 : AV + (tsk - 6) * 64 + sub * 8); const int dp = isq ? 256 : 128;
        for (int r0 = gw; r0 < T; r0 += 2 * ngw) {
            const bool has1 = r0 + ngw < T; const int rr[2] = {r0, has1 ? r0 + ngw : r0};
            u32x4_t w[2]; f32x4 cs[2][4];
#pragma unroll
            for (int k = 0; k < 2; ++k) { const int r = rr[k]; w[k] = *(const u32x4_t*)(Z + (size_t)r * ZW + zc);
                const int tl = r >= NC ? r - NC : 0, pos = (sub >= 4) ? (tl % GW) : (tl / GW); const float* c = RC + pos * 16 + (sub & 1) * 8;
                cs[k][0] = *(const f32x4*)c; cs[k][1] = *(const f32x4*)(c + 4); cs[k][2] = *(const f32x4*)(c + 4096); cs[k][3] = *(const f32x4*)(c + 4100); }
#pragma unroll
            for (int k = 0; k < 2; ++k) {
                float f[8] = {__uint_as_float(w[k].x << 16), __uint_as_float(w[k].x & 0xffff0000u), __uint_as_float(w[k].y << 16), __uint_as_float(w[k].y & 0xffff0000u),
                              __uint_as_float(w[k].z << 16), __uint_as_float(w[k].z & 0xffff0000u), __uint_as_float(w[k].w << 16), __uint_as_float(w[k].w & 0xffff0000u)};
                float ss = 0.f;
#pragma unroll
                for (int e = 0; e < 8; ++e) ss += f[e] * f[e];
                ss += SWZ_XOR(ss, 0x041F); ss += SWZ_XOR(ss, 0x081F); ss += SWZ_XOR(ss, 0x101F);
                const float rs = isn ? rsqrtf(ss * (1.f / 64.f) + EPS) : 1.f;
#pragma unroll
                for (int e = 0; e < 8; ++e) { f[e] = f[e] * rs * g[e];
                    const float pr = SWZ_XOR(f[e], 0x081F);
                    const float c = isn ? cs[k][e >> 2][e & 3] : 1.f, sn = isn ? cs[k][2 + (e >> 2)][e & 3] : 0.f;
                    f[e] = hi ? f[e] * c + pr * sn : f[e] * c - pr * sn; }
                if (k == 0 || has1) { u32x4_t o; o.x = (unsigned)f2bf(f[0]) | ((unsigned)f2bf(f[1]) << 16); o.y = (unsigned)f2bf(f[2]) | ((unsigned)f2bf(f[3]) << 16);
                    o.z = (unsigned)f2bf(f[4]) | ((unsigned)f2bf(f[5]) << 16); o.w = (unsigned)f2bf(f[6]) | ((unsigned)f2bf(f[7]) << 16); *(u32x4_t*)(dbase + (size_t)rr[k] * dp) = o; }
            }
        }
    }
    {
        for (int i0 = gw; i0 < T * 12 / 8; i0 += 2 * ngw) {
            const bool has1 = i0 + ngw < T * 12 / 8; const int ii[2] = {i0, has1 ? i0 + ngw : i0};
            u32x4_t z[2][3]; f32x4 cw[2][3][2]; int rk[2], wk[2], hk[2];
#pragma unroll
            for (int k = 0; k < 2; ++k) { const int gt = ii[k] * 8 + tsk, r = gt / 12, tk = gt % 12, which = tk >> 2, h = tk & 3, ch = which * 256 + h * 64 + sub * 8;
                rk[k] = r; wk[k] = which; hk[k] = h;
                const bool first = (r == 0 || r == NC), last = (r == NC - 1 || r == T - 1);
                const bf16_t* zp = Z + (size_t)r * ZW + ZC_GQ + ch; const float* cp = p.inp(I_CONV) + (size_t)l * 3 * 768 + ch;
                z[k][0] = *(const u32x4_t*)(first ? zp : zp - ZW); z[k][1] = *(const u32x4_t*)zp; z[k][2] = *(const u32x4_t*)(last ? zp : zp + ZW);
                const float m0 = first ? 0.f : 1.f, m2 = last ? 0.f : 1.f;
#pragma unroll
                for (int hh = 0; hh < 2; ++hh) { cw[k][0][hh] = *(const f32x4*)(cp + 4 * hh) * m0; cw[k][1][hh] = *(const f32x4*)(cp + 768 + 4 * hh); cw[k][2][hh] = *(const f32x4*)(cp + 1536 + 4 * hh) * m2; } }
#pragma unroll
            for (int k = 0; k < 2; ++k) {
                float a[8];
#pragma unroll
                for (int e = 0; e < 8; ++e) a[e] = 0.f;
#pragma unroll
                for (int t = 0; t < 3; ++t) { const u32x4_t w = z[k][t];
                    const float f[8] = {__uint_as_float(w.x << 16), __uint_as_float(w.x & 0xffff0000u), __uint_as_float(w.y << 16), __uint_as_float(w.y & 0xffff0000u),
                                        __uint_as_float(w.z << 16), __uint_as_float(w.z & 0xffff0000u), __uint_as_float(w.w << 16), __uint_as_float(w.w & 0xffff0000u)};
#pragma unroll
                    for (int e = 0; e < 8; ++e) a[e] += f[e] * cw[k][t][e >> 2][e & 3]; }
                float ss = 0.f, f[8];
#pragma unroll
                for (int e = 0; e < 8; ++e) { f[e] = a[e] * pg_fsigm(a[e]); ss += f[e] * f[e]; }
                ss += SWZ_XOR(ss, 0x041F); ss += SWZ_XOR(ss, 0x081F); ss += SWZ_XOR(ss, 0x101F);
                const float rs = wk[k] < 2 ? rsqrtf(ss + EPS) * (wk[k] == 0 ? 0.125f : 1.f) : 1.f;
#pragma unroll
                for (int e = 0; e < 8; ++e) f[e] *= rs;
                if (k == 0 || has1) { u32x4_t o; o.x = (unsigned)f2bf(f[0]) | ((unsigned)f2bf(f[1]) << 16); o.y = (unsigned)f2bf(f[2]) | ((unsigned)f2bf(f[3]) << 16);
                    o.z = (unsigned)f2bf(f[4]) | ((unsigned)f2bf(f[5]) << 16); o.w = (unsigned)f2bf(f[6]) | ((unsigned)f2bf(f[7]) << 16);
                    *(u32x4_t*)(GQKV + ((size_t)wk[k] * T + rk[k]) * 256 + hk[k] * 64 + sub * 8) = o; }
            }
        }
    }
}

DEV void ph_rows1(const PV& p, const int l, int bid, int nb, LAS unsigned char* lds3) {
    const int tid = TIDX, lane = tid & 63, wpb = blockDim.x >> 6;
    const int gw = bid * wpb + p.wv, ngw = nb * wpb;
    LAS float* tab = (LAS float*)lds3;
    stage_table16(tab, p.inp(I_WRT) + (size_t)l * 1024 * 16, 16, tid);
    float* XC = wsp<float>(p, WS_XC); const float* YO = wsp<float>(p, WS_YO); bf16_t* H2 = wsp<bf16_t>(p, WS_H); float* AFF = wsp<float>(p, WS_AFF);
    const float* gpo = p.inp(I_GPOM) + l * 1024; const float* gpf = p.inp(I_GPF) + l * 1024;
#pragma unroll 1
    for (int seg = l ? 1 : 0; seg < 2; ++seg) {
        const float* mod = wsp<float>(p, WS_MOD) + (l * 2 + seg) * 6144;
        const float* XI = l ? (const float*)XC : (seg ? p.inp(I_X) - (size_t)NC * 1024 : p.inp(I_CTX));
        f32x4 gg[4], gf[4], sh[4];
#pragma unroll
        for (int j = 0; j < 4; ++j) { const int k0 = j * 256 + lane * 4;
            gg[j] = *(const f32x4*)(mod + 2048 + k0) * *(const f32x4*)(gpo + k0); gf[j] = *(const f32x4*)(gpf + k0) * (1.f + *(const f32x4*)(mod + 4096 + k0)); sh[j] = *(const f32x4*)(mod + 3072 + k0); }
        const int r0 = seg ? NC + gw : gw, rend = seg ? T : NC;
        f32x4 yn[4], xn[4];
        if (r0 < rend) {
#pragma unroll
            for (int j = 0; j < 4; ++j) { yn[j] = *(const f32x4*)(YO + (size_t)r0 * 1024 + j * 256 + lane * 4); xn[j] = *(const f32x4*)(XI + (size_t)r0 * 1024 + j * 256 + lane * 4); }
        }
        for (int r = r0; r < rend; r += ngw) {
            f32x4 y[4], x[4];
#pragma unroll
            for (int j = 0; j < 4; ++j) { y[j] = yn[j]; x[j] = xn[j]; }
            const int rn = r + ngw;
            if (rn < rend) {
#pragma unroll
                for (int j = 0; j < 4; ++j) { yn[j] = *(const f32x4*)(YO + (size_t)rn * 1024 + j * 256 + lane * 4); xn[j] = *(const f32x4*)(XI + (size_t)rn * 1024 + j * 256 + lane * 4); }
            }
            float ss = 0.f;
#pragma unroll
            for (int j = 0; j < 4; ++j) ss += dot4(y[j]);
            const float rs = rsqrtf(wave_sum(ss) * (1.f / 1024.f) + EPS);
            float s2 = 0.f;
#pragma unroll
            for (int j = 0; j < 4; ++j) { x[j] += gg[j] * (y[j] * rs); s2 += dot4(x[j]); *(f32x4*)(XC + (size_t)r * 1024 + j * 256 + lane * 4) = x[j]; }
            const float rs2 = rsqrtf(wave_sum(s2) * (1.f / 1024.f) + EPS);
            f32x4 h[4];
#pragma unroll
            for (int j = 0; j < 4; ++j) { h[j] = x[j] * rs2 * gf[j] + sh[j]; *(uint2*)(H2 + (size_t)r * 1024 + j * 256 + lane * 4) = pack4(h[j]); }
            float lg[16];
#pragma unroll
            for (int i = 0; i < 16; ++i) lg[i] = 0.f;
            dot16(lg, h, tab, lane);
            const float v = reduce16(lg, lane);
            const float ex = expf(v - max16(v));
            const float se = sum16(ex);
            if ((lane & 33) == 0) AFF[(size_t)r * 16 + idx16(lane)] = ex / se;
        }
    }
}

DEV void rows2_issue(const bf16_t* YE, const float* VAL, const float* XC, const int r, const int lane, const int sl, float& vl, uint2 (&ye)[4][4], f32x4 (&x)[4]) {
    const int sc = sl < 0 ? 0 : sl;
    const float vv = VAL[(lane & 15) * EROWS + sc];
    vl = sl < 0 ? 0.f : vv;
    unsigned m = (unsigned)__builtin_amdgcn_ballot_w64(sl >= 0) & 0xffffu;
#pragma unroll
    for (int i = 0; i < 4; ++i) {
        if (m) { const int e = __builtin_ctz(m); m &= m - 1; const int slot = __builtin_amdgcn_readlane(sl, e);
            const bf16_t* yr = YE + ((size_t)e * EROWS + slot) * 1024 + lane * 4;
#pragma unroll
            for (int j = 0; j < 4; ++j) ye[i][j] = *(const uint2*)(yr + j * 256);
        }
    }
#pragma unroll
    for (int j = 0; j < 4; ++j) x[j] = *(const f32x4*)(XC + (size_t)r * 1024 + j * 256 + lane * 4);
}
DEV void acc_ye(f32x4& f, const float v, const uint2 w) { f.x += v * __uint_as_float(w.x << 16); f.y += v * __uint_as_float(w.x & 0xffff0000u); f.z += v * __uint_as_float(w.y << 16); f.w += v * __uint_as_float(w.y & 0xffff0000u); }
DEV void ph_rows2(const PV& p, const int l, int bid, int nb, LAS unsigned char* lds3) {
    const int tid = TIDX, lane = tid & 63, wpb = blockDim.x >> 6;
    const int gw = bid * wpb + p.wv, ngw = nb * wpb;
    LAS float* tab = (LAS float*)lds3;
    if (l == 0) stage_table16(tab, p.inp(I_WIN) + (size_t)1 * 1024 * DIN + 3584, DIN, tid);
    float* XC = wsp<float>(p, WS_XC); const bf16_t* YE = wsp<bf16_t>(p, WS_YE); const int* INV = wsp<int>(p, WS_INV); const float* VAL = wsp<float>(p, WS_VAL);
    const float* gpo = p.inp(I_GPOF) + l * 1024; const float* g1 = p.inp(I_GPM) + 1024;
#pragma unroll 1
    for (int seg = l ? 1 : 0; seg < 2; ++seg) {
        const float* mod = wsp<float>(p, WS_MOD) + (l * 2 + seg) * 6144; const float* mod1 = wsp<float>(p, WS_MOD) + (2 + seg) * 6144;
        f32x4 gg[4], gs[4], sh[4];
#pragma unroll
        for (int j = 0; j < 4; ++j) { const int k0 = j * 256 + lane * 4;
            gg[j] = *(const f32x4*)(mod + 5120 + k0) * *(const f32x4*)(gpo + k0);
            if (l == 0) { gs[j] = *(const f32x4*)(g1 + k0) * (1.f + *(const f32x4*)(mod1 + 1024 + k0)); sh[j] = *(const f32x4*)(mod1 + k0); } }
        const int r0 = seg ? NC + gw : gw, rend = seg ? T : NC;
        int slc = -1, sln = -1; float vlc = 0.f; uint2 yec[4][4]; f32x4 xc[4];
        if (r0 < rend) {
            slc = INV[(size_t)r0 * 16 + (lane & 15)];
            if (r0 + ngw < rend) sln = INV[(size_t)(r0 + ngw) * 16 + (lane & 15)];
            rows2_issue(YE, VAL, XC, r0, lane, slc, vlc, yec, xc);
        }
        for (int r = r0; r < rend; r += ngw) {
            const int sl = slc; const float vl = vlc; uint2 ye[4][4]; f32x4 x[4];
#pragma unroll
            for (int i = 0; i < 4; ++i)
#pragma unroll
                for (int j = 0; j < 4; ++j) ye[i][j] = yec[i][j];
#pragma unroll
            for (int j = 0; j < 4; ++j) x[j] = xc[j];
            const int rn = r + ngw;
            if (rn < rend) {
                slc = sln;
                if (rn + ngw < rend) sln = INV[(size_t)(rn + ngw) * 16 + (lane & 15)];
                rows2_issue(YE, VAL, XC, rn, lane, slc, vlc, yec, xc);
            }
            f32x4 f[4];
#pragma unroll
            for (int j = 0; j < 4; ++j) { const float zf = __uint_as_float(p.z); f[j] = (f32x4){zf, zf, zf, zf}; }
            unsigned m = (unsigned)__builtin_amdgcn_ballot_w64(sl >= 0) & 0xffffu;
#pragma unroll
            for (int i = 0; i < 4; ++i) {
                if (m) { const int e = __builtin_ctz(m); m &= m - 1; const float v = RL(vl, e);
#pragma unroll
                    for (int j = 0; j < 4; ++j) acc_ye(f[j], v, ye[i][j]);
                }
            }
            while (m) { const int e = __builtin_ctz(m); m &= m - 1; const float v = RL(vl, e); const int slot = __builtin_amdgcn_readlane(sl, e);
                const bf16_t* yr = YE + ((size_t)e * EROWS + slot) * 1024 + lane * 4;
#pragma unroll
                for (int j = 0; j < 4; ++j) acc_ye(f[j], v, *(const uint2*)(yr + j * 256));
            }
            float ss = 0.f;
#pragma unroll
            for (int j = 0; j < 4; ++j) ss += dot4(f[j]);
            const float rs = rsqrtf(wave_sum(ss) * (1.f / 1024.f) + EPS);
#pragma unroll
            for (int j = 0; j < 4; ++j) { x[j] += gg[j] * (f[j] * rs);
                if (l == 0) *(f32x4*)(XC + (size_t)r * 1024 + j * 256 + lane * 4) = x[j]; else *(f32x4*)(p.outp() + (size_t)(r - NC) * 1024 + j * 256 + lane * 4) = x[j]; }
            if (l == 0) rows0_core(p, r, lane, x, gs, sh, tab);
        }
    }
}

namespace pg {
typedef short bf16x8 __attribute__((ext_vector_type(8)));
typedef unsigned u32x4 __attribute__((ext_vector_type(4)));
typedef unsigned u32x2 __attribute__((ext_vector_type(2)));
constexpr int BM = 256, BK = 64, HALF = 128, HTB = HALF * BK * 2, STAGE_BYTES = 8 * HTB, NXCD = 8, WGM = 8;
DEV int lds_byte(int r, int c) { const int st = (r >> 4) * 2 + (c >> 5), rr = r & 15, cc = c & 31, ob = rr * 64 + cc * 2; return st * 1024 + (ob ^ (((ob >> 9) & 1) << 5)); }
DEV void stage_rc(int b, int& R, int& C) { const int st = b / 1024, sb = b % 1024, swz = sb ^ (((sb >> 9) & 1) << 5); R = (st >> 1) * 16 + swz / 64; C = (st & 1) * 32 + (swz % 64) / 2; }
DEV int perm32(int rho) { const int n = rho >> 4, i = rho & 15; return 8 * (i >> 2) + 4 * n + (i & 3); }
typedef float f32x2_c __attribute__((ext_vector_type(2))); typedef __bf16 bf16x2_c __attribute__((ext_vector_type(2)));
DEV unsigned cvt_pk_bf16(float lo, float hi) { const f32x2_c v = {lo, hi}; const bf16x2_c b = __builtin_convertvector(v, bf16x2_c); return __builtin_bit_cast(unsigned, b); }
DEV float fsigm(float x) { return __builtin_amdgcn_rcpf(1.f + __builtin_amdgcn_exp2f(-1.4426950408889634f * x)); }

struct Unit { const char* A; const char* B; const int* gidx; int orow, ocol, pm, pn, e; };

struct GridOrder {
    int nM, nN, nwg, G, c;
    DEV void init(int nM_, int nN_, int G_, int c_) { nM = nM_; nN = nN_; nwg = nM * nN; G = G_; c = c_; }
    DEV bool tile(int i, int& pm, int& pn) const {
        const long L = (long)i * G + c; if (L >= nwg) return false;
        int wgid = (int)L; { const int q = nwg / NXCD, r = nwg % NXCD, xcd = wgid % NXCD, off = wgid / NXCD; wgid = (xcd < r ? xcd * (q + 1) : r * (q + 1) + (xcd - r) * q) + off; }
        const int nig = WGM * nN, gid = wgid / nig, fm = gid * WGM, gsz = (nM - fm) < WGM ? (nM - fm) : WGM;
        pm = fm + ((wgid % nig) % gsz); pn = (wgid % nig) / gsz; return true;
    }
};

struct EpiBf16 {
    static constexpr bool PERM = true;
    bf16_t* O; int ldc;
    DEV void operator()(const f32x4 (&acc)[2][2][4][2], const Unit& u, int wr, int wc, int fr, int fq) const {
        const int row0 = u.orow + wr * 64 + fr, col0 = u.ocol + wc * 32 + 8 * fq;
#pragma unroll
        for (int ai = 0; ai < 2; ++ai)
#pragma unroll
            for (int m = 0; m < 4; ++m) { bf16_t* rowp = O + (size_t)(row0 + ai * HALF + m * 16) * ldc + col0;
#pragma unroll
                for (int bj = 0; bj < 2; ++bj) { const f32x4 v0 = acc[ai][bj][m][0], v1 = acc[ai][bj][m][1];
                    u32x4 w; w.x = cvt_pk_bf16(v0[0], v0[1]); w.y = cvt_pk_bf16(v0[2], v0[3]); w.z = cvt_pk_bf16(v1[0], v1[1]); w.w = cvt_pk_bf16(v1[2], v1[3]);
                    *(u32x4*)(rowp + bj * HALF) = w; } }
    }
};

template <class Epi, class Sched, bool ALIGN_EPI, bool GATHER, int K, int lda>
DEV void gemm_phase(LAS unsigned char* lds, const Sched& S, const Epi& E, const unsigned z, const int tid_) {
    const int tid = tid_, wid = __builtin_amdgcn_readfirstlane(tid >> 6), lane = tid & 63, wr = wid >> 2, wc = wid & 3, fr = lane & 15, fq = lane >> 4;
    const int nt = K / BK; const float zf = __uint_as_float(z);
    int Ra[2], Ca[2]; unsigned voffB[2];
#pragma unroll
    for (int i = 0; i < 2; ++i) { int R, C; stage_rc(tid * 16 + i * 8192, R, C); const int Rb = Epi::PERM ? ((R & ~31) + perm32(R & 31)) : R; Ra[i] = R; Ca[i] = C; voffB[i] = (unsigned)(Rb * K + C) * 2u; }
    const size_t kstep = (size_t)(BK * 2);
    const size_t hstepB = (size_t)HALF * K * 2;
    const unsigned ldsw = (unsigned)wid * 1024u;
    const int aoff = lds_byte(wr * 64 + fr, fq * 8), boff = lds_byte(wc * 32 + fr, fq * 8);
#define PG_SA(b, h) (((b) * 2 + (h)) * HTB)
#define PG_SB(b, h) ((4 + (b) * 2 + (h)) * HTB)
#define PG_STAGE_B(bufoff, gbase) do { _Pragma("unroll") for (int _i = 0; _i < 2; ++_i) \
        __builtin_amdgcn_global_load_lds((const unsigned*)((const char*)(gbase) + voffB[_i]), (LAS unsigned*)(lds + (bufoff) + ldsw + _i * 8192), 16, 0, 0); } while (0)
#define PG_STAGE_A(bufoff, gbase, vo) do { _Pragma("unroll") for (int _i = 0; _i < 2; ++_i) \
        __builtin_amdgcn_global_load_lds((const unsigned*)((const char*)(gbase) + (vo)[_i]), (LAS unsigned*)(lds + (bufoff) + ldsw + _i * 8192), 16, 0, 0); } while (0)
#define PG_LDA(dst, b, h) do { _Pragma("unroll") for (int m = 0; m < 4; ++m) _Pragma("unroll") for (int k = 0; k < 2; ++k) dst[m][k] = *(const LAS bf16x8*)(lds + PG_SA(b, h) + aoff + m * 2048 + k * 1024); } while (0)
#define PG_LDB(dst, b, h) do { _Pragma("unroll") for (int n = 0; n < 2; ++n) _Pragma("unroll") for (int k = 0; k < 2; ++k) dst[n][k] = *(const LAS bf16x8*)(lds + PG_SB(b, h) + boff + n * 2048 + k * 1024); } while (0)
#define PG_MMA(ai, bj, At, Bt) do { __builtin_amdgcn_s_setprio(1); _Pragma("unroll") for (int m = 0; m < 4; ++m) _Pragma("unroll") for (int n = 0; n < 2; ++n) _Pragma("unroll") for (int k = 0; k < 2; ++k) \
        acc[ai][bj][m][n] = __builtin_amdgcn_mfma_f32_16x16x32_bf16(Bt[n][k], At[m][k], acc[ai][bj][m][n], 0, 0, 0); __builtin_amdgcn_s_setprio(0); } while (0)
#define PG_WAIT_V(n) asm volatile("s_waitcnt vmcnt(" #n ")" ::: "memory")
#define PG_WAIT_L(n) asm volatile("s_waitcnt lgkmcnt(" #n ")" ::: "memory")
#define PG_BAR __builtin_amdgcn_s_barrier()
#define PG_SCHED __builtin_amdgcn_sched_barrier(0)
#define PG_MKVOFF(u, vo) do { _Pragma("unroll") for (int _h = 0; _h < 2; ++_h) _Pragma("unroll") for (int _i = 0; _i < 2; ++_i) { const int _row = _h * HALF + Ra[_i]; \
        const int _rr = GATHER ? (u).gidx[_row] : _row; (vo)[_h][_i] = (unsigned)(_rr * lda + Ca[_i]) * 2u; } } while (0)
    Unit cur, nxt; int ui = 0;
    if (!S.next(0, cur)) return;
    f32x4 acc[2][2][4][2];
#pragma unroll
    for (int a = 0; a < 2; ++a)
#pragma unroll
        for (int b = 0; b < 2; ++b)
#pragma unroll
            for (int m = 0; m < 4; ++m)
#pragma unroll
                for (int n = 0; n < 2; ++n) acc[a][b][m][n] = (f32x4){zf, zf, zf, zf};
    bf16x8 At[4][2], B0[2][2], B1[2][2];
    unsigned vc[2][2], vn[2][2];
    PG_MKVOFF(cur, vc);
    const char* cA = cur.A; const char* cB = cur.B;
    PG_STAGE_B(PG_SB(0, 0), cB); PG_STAGE_B(PG_SB(0, 1), cB + hstepB); PG_STAGE_A(PG_SA(0, 0), cA, vc[0]); PG_STAGE_A(PG_SA(0, 1), cA, vc[1]);
    if (wr == 1) PG_BAR;
    PG_WAIT_V(2); PG_BAR;
    PG_STAGE_B(PG_SB(1, 0), cB + kstep); PG_STAGE_A(PG_SA(1, 0), cA + kstep, vc[0]); PG_STAGE_B(PG_SB(1, 1), cB + hstepB + kstep);
    PG_WAIT_V(6); PG_BAR;
    for (;;) {
        const bool has_next = S.next(ui + 1, nxt);
        if constexpr (GATHER) { if (has_next) { PG_MKVOFF(nxt, vn); } else {
#pragma unroll
            for (int h = 0; h < 2; ++h)
#pragma unroll
                for (int i = 0; i < 2; ++i) vn[h][i] = vc[h][i]; } }
        const char* nA = has_next ? nxt.A : cA; const char* nB = has_next ? nxt.B : cB;
#pragma unroll 1
        for (int t = 0; t < nt; t += 2) {
            const bool last = (t == nt - 2);
            const char* a1 = cA + (size_t)(t + 1) * kstep;
            const char* a2 = last ? nA : cA + (size_t)(t + 2) * kstep; const char* b2 = last ? nB : cB + (size_t)(t + 2) * kstep;
            const char* a3 = a2 + kstep; const char* b3 = b2 + kstep;
            unsigned v2[2][2];
#pragma unroll
            for (int h = 0; h < 2; ++h)
#pragma unroll
                for (int i = 0; i < 2; ++i) v2[h][i] = (GATHER && last) ? vn[h][i] : vc[h][i];
            PG_LDB(B0, 0, 0); PG_LDB(B1, 0, 1); PG_SCHED; PG_LDA(At, 0, 0); PG_STAGE_A(PG_SA(1, 1), a1, vc[1]);
            PG_WAIT_V(8); PG_WAIT_L(0); PG_BAR; PG_MMA(0, 0, At, B0); PG_MMA(0, 1, At, B1); PG_BAR; PG_SCHED;
            PG_LDA(At, 0, 1); PG_STAGE_B(PG_SB(0, 0), b2); PG_STAGE_B(PG_SB(0, 1), b2 + hstepB); PG_STAGE_A(PG_SA(0, 0), a2, v2[0]);
            PG_WAIT_V(8); PG_WAIT_L(0); PG_BAR; PG_MMA(1, 0, At, B0); PG_MMA(1, 1, At, B1); PG_BAR; PG_SCHED;
            PG_LDB(B0, 1, 0); PG_LDB(B1, 1, 1); PG_SCHED; PG_LDA(At, 1, 0); PG_STAGE_A(PG_SA(0, 1), a2, v2[1]);
            PG_WAIT_V(8); PG_WAIT_L(0); PG_BAR; PG_MMA(0, 0, At, B0); PG_MMA(0, 1, At, B1); PG_BAR; PG_SCHED;
            PG_LDA(At, 1, 1); PG_STAGE_B(PG_SB(1, 0), b3); PG_STAGE_B(PG_SB(1, 1), b3 + hstepB); PG_STAGE_A(PG_SA(1, 0), a3, v2[0]);
            PG_WAIT_V(8); PG_WAIT_L(0); PG_BAR; PG_MMA(1, 0, At, B0); PG_MMA(1, 1, At, B1); PG_BAR; PG_SCHED;
        }
        if constexpr (ALIGN_EPI) { if (wr == 0) PG_BAR; }
        E(acc, cur, wr, wc, fr, fq);
        if (!has_next) break;
#pragma unroll
        for (int a = 0; a < 2; ++a)
#pragma unroll
            for (int b = 0; b < 2; ++b)
#pragma unroll
                for (int m = 0; m < 4; ++m)
#pragma unroll
                    for (int n = 0; n < 2; ++n) acc[a][b][m][n] = (f32x4){zf, zf, zf, zf};
        cur = nxt; cA = nA; cB = nB; ++ui;
        if constexpr (GATHER) {
#pragma unroll
        for (int h = 0; h < 2; ++h)
#pragma unroll
            for (int i = 0; i < 2; ++i) vc[h][i] = vn[h][i]; }
        if constexpr (ALIGN_EPI) { if (wr == 1) PG_BAR; }
    }
    PG_WAIT_V(0);
    if constexpr (!ALIGN_EPI) { if (wr == 0) PG_BAR; }
    PG_BAR;
}
}

constexpr size_t WS_W = 389 * MiB;
constexpr size_t WO_WIN = 0, WO_WM = WO_WIN + (size_t)ZW * 1024 * 2, WO_WB = WO_WM + (size_t)4096 * 1024 * 2, WO_WO = WO_WB + (size_t)4096 * 256 * 2,
                 WO_WGU = WO_WO + (size_t)1024 * 1024 * 2, WO_WD = WO_WGU + (size_t)NE * 2048 * 1024 * 2, WO_END = WO_WD + (size_t)NE * 1024 * 1024 * 2;
static_assert(WS_W + WO_END <= 505 * MiB, "weight region");
DEV void cvt_locate(const PV& p, const int l, int r, const int lane, const float*& src, size_t& ld, bf16_t*& dst, int& K) {
    constexpr int I_A = (ZW / 32) * 16, I_B = 128 * 16, I_C = 128 * 4, I_D = 32 * 16, I_E = NE * 64 * 16;
    unsigned char* W = p.wsb() + WS_W; const int c4 = 4 * (lane & 7), kr = lane >> 3;
    if (r < I_A) { const int nb_ = r / 16, k0 = (r % 16) * 64, n = nb_ * 32 + c4, oc = n < 3584 ? n : n + 16;
        src = p.inp(I_WIN) + (size_t)l * 1024 * DIN + (size_t)(k0 + kr) * DIN + oc; ld = DIN; dst = (bf16_t*)(W + WO_WIN) + (size_t)(nb_ * 32) * 1024 + k0; K = 1024; return; } r -= I_A;
    if (r < I_B) { const int nb_ = r / 16, k0 = (r % 16) * 64, c0 = nb_ * 32, pn = c0 >> 8, bj = (c0 >> 7) & 1, wc = (c0 >> 5) & 3, n_ = c4 >> 4, x = c4 & 15, n4 = 2 * bj + n_, j = 64 * pn + 16 * wc + x;
        src = p.inp(I_WMG) + ((size_t)l * 4 + n4) * 1024 * 1024 + (size_t)(k0 + kr) * 1024 + j; ld = 1024; dst = (bf16_t*)(W + WO_WM) + (size_t)c0 * 1024 + k0; K = 1024; return; } r -= I_B;
    if (r < I_C) { const int nb_ = r / 4, k0 = (r % 4) * 64, c0 = nb_ * 32, n4 = c0 >> 10, j = (c0 & 1023) + c4;
        src = p.inp(I_WBR) + ((size_t)l * 4 + n4) * 256 * 1024 + (size_t)(k0 + kr) * 1024 + j; ld = 1024; dst = (bf16_t*)(W + WO_WB) + (size_t)c0 * 256 + k0; K = 256; return; } r -= I_C;
    if (r < I_D) { const int nb_ = r / 16, k0 = (r % 16) * 64;
        src = p.inp(I_WOUT) + (size_t)l * 1024 * 1024 + (size_t)(k0 + kr) * 1024 + nb_ * 32 + c4; ld = 1024; dst = (bf16_t*)(W + WO_WO) + (size_t)(nb_ * 32) * 1024 + k0; K = 1024; return; } r -= I_D;
    if (r < I_E) { const int e = r / (64 * 16), rr = r % (64 * 16), nb_ = rr % 64, k0 = (rr / 64) * 64, c0 = nb_ * 32, pn = c0 >> 8, bj = (c0 >> 7) & 1, cc = (c0 & 127) + c4;
        src = (bj ? p.inp(I_WEU) : p.inp(I_WEG)) + ((size_t)l * NE + e) * 1024 * 1024 + (size_t)(k0 + kr) * 1024 + 128 * pn + cc; ld = 1024;
        dst = (bf16_t*)(W + WO_WGU) + ((size_t)e * 2048 + c0) * 1024 + k0; K = 1024; return; } r -= I_E;
    { const int e = r / (32 * 16), rr = r % (32 * 16), nb_ = rr % 32, k0 = (rr / 32) * 64;
        src = p.inp(I_WED) + ((size_t)l * NE + e) * 1024 * 1024 + (size_t)(k0 + kr) * 1024 + nb_ * 32 + c4; ld = 1024; dst = (bf16_t*)(W + WO_WD) + ((size_t)e * 1024 + nb_ * 32) * 1024 + k0; K = 1024; }
}
DEV void cvt_store(const f32x4 (&v)[8], bf16_t* dst, const int K, LAS float* scr, const int lane) {
    { const int kr = lane >> 3, x = lane & 7, sh = 8 * ((x >> 2) & 1);
#pragma unroll
      for (int i = 0; i < 8; ++i)
#pragma unroll
        for (int e = 0; e < 4; ++e) scr[(4 * x + e) * 68 + ((8 * i + kr + sh) & 63)] = v[i][e]; }
    const int c = lane & 7;
#pragma unroll
    for (int j = 0; j < 4; ++j) { const int n = (lane >> 3) + 8 * j; const LAS float* s = scr + n * 68 + ((8 * c + 8 * ((n >> 4) & 1)) & 63);
        const f32x4 lo = *(const LAS f32x4*)s, hi = *(const LAS f32x4*)(s + 4);
        pg::u32x4 o; o.x = pg::cvt_pk_bf16(lo.x, lo.y); o.y = pg::cvt_pk_bf16(lo.z, lo.w); o.z = pg::cvt_pk_bf16(hi.x, hi.y); o.w = pg::cvt_pk_bf16(hi.z, hi.w);
        *(pg::u32x4*)(dst + (size_t)n * K + 8 * c) = o; }
}
DEV void ph_wconv(const PV& p, const int l, int bid, int nb, LAS unsigned char* lds3, const int part  ) {
    const int lane = TIDX & 63, wave = p.wv;
    LAS float* scr = (LAS float*)(lds3 + wave * 8704);
    constexpr int I_A = (ZW / 32) * 16, I_B = 128 * 16, I_C = 128 * 4, I_D = 32 * 16, I_E = NE * 64 * 16, I_F = NE * 32 * 16;
    constexpr int NITEMS = I_A + I_B + I_C + I_D + I_E + I_F;
    const int it0 = part ? I_A + I_B + I_C + I_D : 0, it1 = part ? NITEMS : I_A + I_B + I_C + I_D;
    const int skip = part ? (l == 0 ? 2 * NE : NE) : 0;
    if (bid < skip) return;
    const int step = (nb - skip) * 8;
    int it = it0 + (bid - skip) * 8 + wave;
    const float* src; size_t ld; bf16_t* dst; int K; f32x4 vn[8];
    if (it < it1) { cvt_locate(p, l, it, lane, src, ld, dst, K);
#pragma unroll
        for (int i = 0; i < 8; ++i) vn[i] = *(const f32x4*)(src + (size_t)(8 * i) * ld); }
    while (it < it1) {
        f32x4 v[8]; bf16_t* dc = dst; const int Kc = K;
#pragma unroll
        for (int i = 0; i < 8; ++i) v[i] = vn[i];
        it += step;
        if (it < it1) { cvt_locate(p, l, it, lane, src, ld, dst, K);
#pragma unroll
            for (int i = 0; i < 8; ++i) vn[i] = *(const f32x4*)(src + (size_t)(8 * i) * ld); }
        cvt_store(v, dc, Kc, scr, lane);
    }
}

struct SchedG1 { pg::GridOrder o; const char* A; const char* B;
    DEV bool next(int i, pg::Unit& u) const { int pm, pn; if (!o.tile(i, pm, pn)) return false;
        u.A = A + (size_t)pm * 256 * 1024 * 2; u.B = B + (size_t)pn * 256 * 1024 * 2; u.gidx = nullptr; u.orow = pm * 256; u.ocol = pn * 256; u.pm = pm; u.pn = pn; u.e = 0; return true; } };
DEV void ph_g1_fast(const PV& p, int bid, int nb, LAS unsigned char* lds3) {
    SchedG1 S; S.o.init(T / 256, ZW / 256, nb, bid); S.A = (const char*)(p.wsb() + WS_H); S.B = (const char*)(p.wsb() + WS_W + WO_WIN);
    pg::EpiBf16 E{wsp<bf16_t>(p, WS_Z), ZW};
    pg::gemm_phase<pg::EpiBf16, SchedG1, true, false, 1024, 1024>(lds3, S, E, p.z, p.tid());
}

namespace pg {
struct EpiF32 {
    static constexpr bool PERM = false;
    float* O; int ldc;
    DEV void operator()(const f32x4 (&acc)[2][2][4][2], const Unit& u, int wr, int wc, int fr, int fq) const {
        const int row0 = u.orow + wr * 64 + fr, col0 = u.ocol + wc * 32 + 4 * fq;
#pragma unroll
        for (int ai = 0; ai < 2; ++ai)
#pragma unroll
            for (int m = 0; m < 4; ++m) { float* rowp = O + (size_t)(row0 + ai * HALF + m * 16) * ldc + col0;
#pragma unroll
                for (int bj = 0; bj < 2; ++bj)
#pragma unroll
                    for (int n = 0; n < 2; ++n) *(f32x4*)(rowp + bj * HALF + n * 16) = acc[ai][bj][m][n]; }
    }
};
struct EpiMerge {
    static constexpr bool PERM = false;
    const bf16_t* Bb; bf16_t* Mo;
    DEV void operator()(const f32x4 (&acc)[2][2][4][2], const Unit& u, int wr, int wc, int fr, int fq) const {
        const int row0 = u.orow + wr * 64 + fr, jb = u.pn * 64 + 16 * wc + 4 * fq;
#pragma unroll
        for (int ai = 0; ai < 2; ++ai)
#pragma unroll
            for (int m = 0; m < 4; ++m) { const int row = row0 + ai * HALF + m * 16; const bf16_t* bp = Bb + (size_t)row * 4096 + jb;
                f32x4 s = (f32x4){0.f, 0.f, 0.f, 0.f};
#pragma unroll
                for (int bj = 0; bj < 2; ++bj)
#pragma unroll
                    for (int n = 0; n < 2; ++n) { const u32x2 w = *(const u32x2*)(bp + (2 * bj + n) * 1024); const f32x4 a = acc[ai][bj][m][n];
                        s[0] += fsigm(a[0]) * __uint_as_float(w.x << 16); s[1] += fsigm(a[1]) * __uint_as_float(w.x & 0xffff0000u);
                        s[2] += fsigm(a[2]) * __uint_as_float(w.y << 16); s[3] += fsigm(a[3]) * __uint_as_float(w.y & 0xffff0000u); }
                u32x2 o; o.x = cvt_pk_bf16(s[0], s[1]); o.y = cvt_pk_bf16(s[2], s[3]);
                *(u32x2*)(Mo + (size_t)row * 1024 + jb) = o; }
    }
};
struct EpiAct {
    static constexpr bool PERM = true;
    bf16_t* O;
    DEV void operator()(const f32x4 (&acc)[2][2][4][2], const Unit& u, int wr, int wc, int fr, int fq) const {
        const int row0 = u.orow + wr * 64 + fr, col0 = u.ocol + wc * 32 + 8 * fq;
#pragma unroll
        for (int ai = 0; ai < 2; ++ai)
#pragma unroll
            for (int m = 0; m < 4; ++m) { const f32x4 g0 = acc[ai][0][m][0], g1 = acc[ai][0][m][1], u0 = acc[ai][1][m][0], u1 = acc[ai][1][m][1];
                float a[8];
#pragma unroll
                for (int e = 0; e < 4; ++e) { a[e] = g0[e] * fsigm(g0[e]) * u0[e]; a[4 + e] = g1[e] * fsigm(g1[e]) * u1[e]; }
                u32x4 w; w.x = cvt_pk_bf16(a[0], a[1]); w.y = cvt_pk_bf16(a[2], a[3]); w.z = cvt_pk_bf16(a[4], a[5]); w.w = cvt_pk_bf16(a[6], a[7]);
                *(u32x4*)(O + (size_t)(row0 + ai * HALF + m * 16) * 1024 + col0) = w; }
    }
};
}
struct SchedDense { pg::GridOrder o; const char* A; const char* B; int pm0, lda, K, acol_shift  ;
    DEV bool next(int i, pg::Unit& u) const { int pm, pn; if (!o.tile(i, pm, pn)) return false; pm += pm0;
        u.A = A + ((size_t)pm * 256 * lda + (acol_shift >= 0 ? (size_t)(pn >> acol_shift) * K : 0)) * 2; u.B = B + (size_t)pn * 256 * K * 2;
        u.gidx = nullptr; u.orow = pm * 256; u.ocol = pn * 256; u.pm = pm; u.pn = pn; u.e = 0; return true; } };
struct SchedExp { pg::GridOrder o; const char* A; const char* B; const int* idx; int RT, ntn, ocol_w; bool gather;
    DEV bool next(int i, pg::Unit& u) const { int pm, pn; if (!o.tile(i, pm, pn)) return false; const int e = pm / RT, rt = pm % RT, row = e * EROWS + rt * 256;
        u.A = gather ? A : A + (size_t)row * 1024 * 2; u.gidx = idx + row; u.B = B + ((size_t)e * ntn + pn) * 256 * 1024 * 2;
        u.orow = row; u.ocol = pn * ocol_w; u.pm = pm; u.pn = pn; u.e = e; return true; } };

DEV void ph_g2_fast(const PV& p, const int l, int bid, int nb, LAS unsigned char* lds3) {
    SchedDense S; S.o.init(T / 256 - l, 16, nb, bid); S.A = (const char*)(p.wsb() + WS_Y); S.B = (const char*)(p.wsb() + WS_W + WO_WB); S.pm0 = l; S.lda = 1024; S.K = 256; S.acol_shift = 2;
    pg::EpiBf16 E{wsp<bf16_t>(p, WS_Z), 4096};
    pg::gemm_phase<pg::EpiBf16, SchedDense, true, false, 256, 1024>(lds3, S, E, p.z, p.tid());
}
struct SchedOne { const char* A; const char* B; int pm, pn, lda, K;
    DEV bool next(int i, pg::Unit& u) const { if (i > 0) return false;
        u.A = A + (size_t)pm * 256 * lda * 2; u.B = B + (size_t)pn * 256 * K * 2; u.gidx = nullptr; u.orow = pm * 256; u.ocol = pn * 256; u.pm = pm; u.pn = pn; u.e = 0; return true; } };
constexpr int XD_CTXCNT = 8192;
DEV void ph_g3_fast(const PV& p, const int l, int bid, int nb, LAS unsigned char* lds3) {
    pg::EpiMerge E{wsp<bf16_t>(p, WS_Z), wsp<bf16_t>(p, WS_M)};
    unsigned* cnt = (unsigned*)p.wsb() + XD_CTXCNT;
    const bool oob = (l == 0) && nb >= 20;
    if (oob && bid < 16) {
        SchedOne S1{(const char*)(p.wsb() + WS_H), (const char*)(p.wsb() + WS_W + WO_WM), 0, bid, 1024, 1024};
        pg::gemm_phase<pg::EpiMerge, SchedOne, true, false, 1024, 1024>(lds3, S1, E, p.z, p.tid());
        asm volatile("s_waitcnt vmcnt(0)" ::: "memory");
        __syncthreads();
        if (p.tid() == 0) { __builtin_amdgcn_fence(__ATOMIC_RELEASE, "agent"); asm volatile("s_waitcnt vmcnt(0)" ::: "memory");
            (void)__hip_atomic_fetch_add(cnt, 1u, __ATOMIC_RELAXED, __HIP_MEMORY_SCOPE_AGENT); }
    }
    {   SchedDense S; S.o.init(oob ? 64 : T / 256 - l, 16, nb, bid); S.A = (const char*)(p.wsb() + WS_H); S.B = (const char*)(p.wsb() + WS_W + WO_WM); S.pm0 = oob ? 1 : l; S.lda = 1024; S.K = 1024; S.acol_shift = -1;
        pg::gemm_phase<pg::EpiMerge, SchedDense, true, false, 1024, 1024>(lds3, S, E, p.z, p.tid()); }
    if (oob && bid >= 16 && bid < 20) {
        if (p.tid() == 0) { unsigned sp = 0; while (__hip_atomic_load(cnt, __ATOMIC_RELAXED, __HIP_MEMORY_SCOPE_AGENT) < 16u) { __builtin_amdgcn_s_sleep(2); if (++sp > (1u << 22)) break; } }
        __syncthreads();
        __builtin_amdgcn_fence(__ATOMIC_ACQUIRE, "agent");
        asm volatile("s_waitcnt vmcnt(0)" ::: "memory");
        SchedOne S1{(const char*)(p.wsb() + WS_M), (const char*)(p.wsb() + WS_W + WO_WO), 0, bid - 16, 1024, 1024};
        pg::EpiF32 E4{wsp<float>(p, WS_YO), 1024};
        pg::gemm_phase<pg::EpiF32, SchedOne, true, false, 1024, 1024>(lds3, S1, E4, p.z, p.tid());
    }
}
DEV void ph_g4_fast(const PV& p, const int l, int bid, int nb, LAS unsigned char* lds3) {
    const bool oob = (l == 0) && nb >= 20;
    SchedDense S; S.o.init(oob ? 64 : T / 256 - l, 4, nb, bid); S.A = (const char*)(p.wsb() + WS_M); S.B = (const char*)(p.wsb() + WS_W + WO_WO); S.pm0 = oob ? 1 : l; S.lda = 1024; S.K = 1024; S.acol_shift = -1;
    pg::EpiF32 E{wsp<float>(p, WS_YO), 1024};
    pg::gemm_phase<pg::EpiF32, SchedDense, true, false, 1024, 1024>(lds3, S, E, p.z, p.tid());
}
DEV void ph_g5_fast(const PV& p, const int l, int bid, int nb, LAS unsigned char* lds3) {
    SchedExp S; S.RT = l ? 8 : 9; S.o.init(NE * S.RT, 8, nb, bid); S.A = (const char*)(p.wsb() + WS_H); S.B = (const char*)(p.wsb() + WS_W + WO_WGU); S.idx = wsp<int>(p, WS_IDX); S.ntn = 8; S.ocol_w = 128; S.gather = true;
    pg::EpiAct E{wsp<bf16_t>(p, WS_ACT)};
    pg::gemm_phase<pg::EpiAct, SchedExp, true, true, 1024, 1024>(lds3, S, E, p.z, p.tid());
}
DEV void ph_g6_fast(const PV& p, const int l, int bid, int nb, LAS unsigned char* lds3) {
    SchedExp S; S.RT = l ? 8 : 9; S.o.init(NE * S.RT, 4, nb, bid); S.A = (const char*)(p.wsb() + WS_ACT); S.B = (const char*)(p.wsb() + WS_W + WO_WD); S.idx = wsp<int>(p, WS_IDX); S.ntn = 4; S.ocol_w = 256; S.gather = false;
    pg::EpiBf16 E{wsp<bf16_t>(p, WS_YE), 1024};
    pg::gemm_phase<pg::EpiBf16, SchedExp, true, false, 1024, 1024>(lds3, S, E, p.z, p.tid());
}

#define ATTN_STORE16(p,v) (*(u32x4*)(p)=(v))
namespace attn_body {
using bf16=unsigned short;
using bf16x8=__attribute__((ext_vector_type(8)))short;
using s16x4=__attribute__((ext_vector_type(4)))short;
using f32x16=__attribute__((ext_vector_type(16)))float;
using u32x4=__attribute__((ext_vector_type(4)))unsigned;
constexpr int D=64,QP=256,KP=128,OP=1024;
constexpr int NW=8,QBLK=32,QB=QBLK*NW,KVBLK=64;
__device__ __forceinline__ int crow(int r,int hi){return (r&3)+8*(r>>2)+4*hi;}
#define SBAR() __builtin_amdgcn_sched_barrier(0)
constexpr int NSLOT=3, SLOTB=8192;
constexpr int LDS_K=0, LDS_V=NSLOT*SLOTB, LDS_WS=2*NSLOT*SLOTB, LDS_OST=LDS_WS+NW*64*4, LDS_BYTES=LDS_OST+NW*4096;
constexpr float C2=0.125f*1.4426950408889634f;
__device__ __forceinline__ void glds16(const void*gsrc,unsigned lds_dst){unsigned keep;
  asm volatile("s_mov_b32 %0, m0\n\ts_mov_b32 m0, %2\n\ts_nop 0\n\tglobal_load_lds_dwordx4 %1, off\n\ts_mov_b32 m0, %0":"=&s"(keep):"v"(gsrc),"s"(lds_dst):"memory");}
__device__ __forceinline__ float max3f(float a,float b,float c){float r;asm("v_max3_f32 %0, %1, %2, %3":"=v"(r):"v"(a),"v"(b),"v"(c));return r;}
__device__ __forceinline__ float max2f(float a,float b){float r;asm("v_max_f32_e32 %0, %1, %2":"=v"(r):"v"(a),"v"(b));return r;}
__device__ __forceinline__ float fadd_s(float a,float b){float r;asm("v_add_f32_e32 %0, %1, %2":"=v"(r):"v"(a),"v"(b));return r;}
__device__ __forceinline__ float fsub_s(float a,float b){float r;asm("v_sub_f32_e32 %0, %1, %2":"=v"(r):"v"(a),"v"(b));return r;}
typedef float f32x2_t __attribute__((ext_vector_type(2))); typedef __bf16 bf16x2_t __attribute__((ext_vector_type(2)));
__device__ __forceinline__ unsigned cvtpk_s(float lo,float hi){f32x2_t v={lo,hi};bf16x2_t b=__builtin_convertvector(v,bf16x2_t);return __builtin_bit_cast(unsigned,b);}
#define WAIT_BAR(N) asm volatile("s_waitcnt vmcnt(" #N ") lgkmcnt(0)\n\ts_barrier":::"memory")

__device__ __forceinline__ void qkt(f32x16&p0,f32x16&p1,const char*Kslot,const bf16x8*qr,const f32x16&negm,int r32,int hi){
  const char*kb=Kslot+hi*1024+r32*16;
  #pragma unroll
  for(int d0=0;d0<4;++d0){
    const bf16x8 b0=*reinterpret_cast<const bf16x8*>(kb+d0*2048);
    const bf16x8 b1=*reinterpret_cast<const bf16x8*>(kb+d0*2048+512);
    if(d0==0){p0=__builtin_amdgcn_mfma_f32_32x32x16_bf16(b0,qr[0],negm,0,0,0);p1=__builtin_amdgcn_mfma_f32_32x32x16_bf16(b1,qr[0],negm,0,0,0);}
    else{p0=__builtin_amdgcn_mfma_f32_32x32x16_bf16(b0,qr[d0],p0,0,0,0);p1=__builtin_amdgcn_mfma_f32_32x32x16_bf16(b1,qr[d0],p1,0,0,0);}}
}
typedef __attribute__((address_space(3))) const char* lds_cptr;
typedef short v4i16_t __attribute__((ext_vector_type(4)));
__device__ __forceinline__ void kload8(bf16x8*kf,lds_cptr kp){
  kf[0]=*(const __attribute__((address_space(3))) bf16x8*)(kp);      kf[1]=*(const __attribute__((address_space(3))) bf16x8*)(kp+512);
  kf[2]=*(const __attribute__((address_space(3))) bf16x8*)(kp+2048); kf[3]=*(const __attribute__((address_space(3))) bf16x8*)(kp+2560);
  kf[4]=*(const __attribute__((address_space(3))) bf16x8*)(kp+4096); kf[5]=*(const __attribute__((address_space(3))) bf16x8*)(kp+4608);
  kf[6]=*(const __attribute__((address_space(3))) bf16x8*)(kp+6144); kf[7]=*(const __attribute__((address_space(3))) bf16x8*)(kp+6656);
}
__device__ __forceinline__ void kload2(bf16x8*kf,lds_cptr kp,int j){ kf[2*j]=*(const __attribute__((address_space(3))) bf16x8*)(kp+j*2048); kf[2*j+1]=*(const __attribute__((address_space(3))) bf16x8*)(kp+j*2048+512); }
__device__ __forceinline__ s16x4 vtr(lds_cptr p){ return __builtin_bit_cast(s16x4,__builtin_amdgcn_ds_read_tr16_b64_v4i16((__attribute__((address_space(3))) v4i16_t*)p)); }
__device__ __forceinline__ float rowmax(const f32x16&p0,const f32x16&p1){
  float a=max3f(p0[0],p0[1],p1[0]),b=max3f(p0[2],p0[3],p1[1]);a=max3f(a,p1[2],p1[3]);
  #pragma unroll
  for(int r=4;r<16;r+=4){a=max3f(a,p0[r],p0[r+1]);b=max3f(b,p0[r+2],p0[r+3]);a=max3f(a,p1[r],p1[r+1]);b=max3f(b,p1[r+2],p1[r+3]);}
  const float m=max2f(a,b);
  auto rr=__builtin_amdgcn_permlane32_swap(__float_as_uint(m),__float_as_uint(m),false,false);
  return max2f(__uint_as_float(rr[0]),__uint_as_float(rr[1]));
}
__device__ __forceinline__ void pv(f32x16*o,int vb,bf16x8 pa0,bf16x8 pa1,bf16x8 pa2,bf16x8 pa3){
  #pragma unroll
  for(int d0=0;d0<2;++d0){s16x4 lo[4],hi[4];
    #pragma unroll
    for(int ks=0;ks<4;++ks){
      asm volatile("ds_read_b64_tr_b16 %0,%1 offset:%c2":"=&v"(lo[ks]):"v"(vb),"i"(d0*4096+ks*1024):"memory");
      asm volatile("ds_read_b64_tr_b16 %0,%1 offset:%c2":"=&v"(hi[ks]):"v"(vb),"i"(d0*4096+ks*1024+512):"memory");}
    asm volatile("s_waitcnt lgkmcnt(0)":::"memory");SBAR();
    #define PK(k) (bf16x8){lo[k][0],lo[k][1],lo[k][2],lo[k][3],hi[k][0],hi[k][1],hi[k][2],hi[k][3]}
    o[d0]=__builtin_amdgcn_mfma_f32_32x32x16_bf16(pa0,PK(0),o[d0],0,0,0);
    o[d0]=__builtin_amdgcn_mfma_f32_32x32x16_bf16(pa1,PK(1),o[d0],0,0,0);
    o[d0]=__builtin_amdgcn_mfma_f32_32x32x16_bf16(pa2,PK(2),o[d0],0,0,0);
    o[d0]=__builtin_amdgcn_mfma_f32_32x32x16_bf16(pa3,PK(3),o[d0],0,0,0);
    #undef PK
  }
}

#ifndef ATTN_STORE16
#define ATTN_STORE16(p,v) (*(u32x4*)(p)=(v))
#endif
template<int THRL,bool NOMAX=false> __device__ __forceinline__ void attn_unit(const int hq,const int row0,const int NT,const bf16*Q,const bf16*__restrict__ K,const bf16*__restrict__ V,bf16*O,char*shm,const unsigned z,const int tid_){
  const int tid=tid_,lane=tid&63,r32=lane&31,hi=lane>>5; const int wid=__builtin_amdgcn_readfirstlane(tid>>6);
  const bf16*Qw=Q+(long)(row0+wid*QBLK)*QP+hq*D;
  const bf16*Kh=K+(hq>>1)*D,*Vh=V+(hq>>1)*D;
  const unsigned lds0=(unsigned)(uintptr_t)shm;
  float*wsf=(float*)(shm+LDS_WS)+wid*64;
  const bf16*ksrc=Kh+(long)lane*KP+wid*8;
  const bf16*vsrc=Vh+(long)(16*(wid&3)+(lane>>2))*KP+(wid>>2)*32+(lane&3)*8;
  const unsigned kdst=lds0+LDS_K+wid*1024, vdst=lds0+LDS_V+wid*1024;
  #define DMA_K(t,slot) glds16(ksrc+(long)(t)*KVBLK*KP,(unsigned)__builtin_amdgcn_readfirstlane(kdst+(slot)))
  #define DMA_V(t,slot) glds16(vsrc+(long)(t)*KVBLK*KP,(unsigned)__builtin_amdgcn_readfirstlane(vdst+(slot)))
  const int vb0=(int)(lds0+LDS_V)+((lane>>4)&1)*32+(lane&3)*8+(4*hi+((lane&15)>>2))*64;
  const char*Kbase=shm+LDS_K; bf16x8 kf[8];
  const lds_cptr shm3=(lds_cptr)shm; const lds_cptr kp0=shm3+LDS_K+hi*1024+r32*16; const lds_cptr vp0=shm3+LDS_V+((lane>>4)&1)*32+(lane&3)*8+(4*hi+((lane&15)>>2))*64;
  DMA_K(0,0);DMA_V(0,0);DMA_K(1,SLOTB);
  bf16x8 qr[4];
  #pragma unroll
  for(int d0=0;d0<4;++d0)qr[d0]=*reinterpret_cast<const bf16x8*>(&Qw[(long)r32*QP+d0*16+hi*8]);
  const float zf_=__uint_as_float(z); float mhat=zf_,l_reg=zf_;f32x16 o[2],negm;
  _Pragma("unroll") for(int r_=0;r_<16;++r_){o[0][r_]=zf_;o[1][r_]=zf_;negm[r_]=zf_;} asm volatile("":"+v"(negm));
  #define CMASK(P0,P1,t) do{}while(0)
  bool resc=false;
  #define START(P0,P1) do{ resc=false; \
    if constexpr(!NOMAX){ const float rm=rowmax(P0,P1); const float dl=rm; mhat=fadd_s(mhat,dl); \
      _Pragma("unroll") for(int r=0;r<16;++r){P0[r]=fsub_s(P0[r],dl);P1[r]=fsub_s(P1[r],dl);} \
      _Pragma("unroll") for(int r=0;r<16;++r)negm[r]=-mhat; asm volatile("":"+v"(negm)); } \
    _Pragma("unroll") for(int r=0;r<16;++r)P0[r]=__builtin_amdgcn_exp2f(P0[r]); }while(0)
  #define RESC() do{ if(resc){ asm volatile("s_waitcnt lgkmcnt(0)":::"memory"); \
      _Pragma("unroll") for(int d_=0;d_<2;++d_) _Pragma("unroll") for(int r=0;r<16;++r)o[d_][r]*=wsf[crow(r,hi)]; } }while(0)
  f32x16 pA0,pA1,pB0,pB1;
  int sl_prev=0,sl_cur=0,sl_next=SLOTB;
  #define ROT() do{sl_prev=sl_cur;sl_cur=sl_next;sl_next=(sl_next==(NSLOT-1)*SLOTB)?0:sl_next+SLOTB;}while(0)
  DMA_K(2,2*SLOTB);
  WAIT_BAR(3);
  qkt(pA0,pA1,Kbase,qr,negm,r32,hi);asm volatile("s_nop 15\n\ts_nop 7":"+v"(pA0),"+v"(pA1));CMASK(pA0,pA1,0);
  START(pA0,pA1);
  _Pragma("unroll") for(int r=0;r<16;++r)pA1[r]=__builtin_amdgcn_exp2f(pA1[r]);
  WAIT_BAR(0);
  DMA_K(3,0);DMA_V(1,SLOTB);
  ROT();
  kload8(kf,kp0+sl_cur);
  WAIT_BAR(2);
  s16x4 vlo[8],vhi[8]; u32x4 pw0,pw1,pw2,pw3;
  #define PKW(P,B) cvtpk_s(P[B],P[B+1])
  #define PAF(k) __builtin_bit_cast(bf16x8,pw##k)
  #define VFR(i) (bf16x8){vlo[i][0],vlo[i][1],vlo[i][2],vlo[i][3],vhi[i][0],vhi[i][1],vhi[i][2],vhi[i][3]}
  #define PIN(x) asm volatile("":"+v"(x))
  #define MX3(a,b,c) __builtin_fmaxf(__builtin_fmaxf((a),(b)),(c))
  #define GAPA(MF,A0,A1,A2,A3,W0,W1,PW) do{ MF; sacc+=A0; sacc+=A1; sacc+=A2; sacc+=A3; PIN(sacc); W0; W1; PIN(PW); SBAR(); }while(0)
  #define EX(v) __builtin_amdgcn_exp2f(v)
  #define GAPB(MF,X,B) do{ MF; X[B]=EX(X[B]); X[B+1]=EX(X[B+1]); X[B+2]=EX(X[B+2]); X[B+3]=EX(X[B+3]); PIN(X); SBAR(); }while(0)
  #define VRD(i) do{ vlo[i]=vtr(vp_+(((i)>>2)*4096+((i)&3)*1024)); vhi[i]=vtr(vp_+(((i)>>2)*4096+((i)&3)*1024+512)); }while(0)
  #define KRD(G,j) do{ if(G){ kload2(kf,kp0+sl_next,j); SBAR(); } }while(0)
  #define STEP(C0,C1,P0,P1,t,GK,GV,GL) do{ SBAR(); \
    const lds_cptr vp_=vp0+sl_prev; \
    VRD(0); SBAR(); float sacc=(P0[0]+P0[1]); \
    GAPA(C0=__builtin_amdgcn_mfma_f32_32x32x16_bf16(kf[0],qr[0],negm,0,0,0), P0[2],P0[3],P0[4],P0[5],     pw0[0]=PKW(P0,0), pw0[1]=PKW(P0,2), pw0); \
    VRD(4); SBAR(); GAPA(C1=__builtin_amdgcn_mfma_f32_32x32x16_bf16(kf[1],qr[0],negm,0,0,0), P0[6],P0[7],P0[8],P0[9],     pw0[2]=PKW(P0,4), pw0[3]=PKW(P0,6), pw0); \
    VRD(1); SBAR(); GAPA(C0=__builtin_amdgcn_mfma_f32_32x32x16_bf16(kf[2],qr[1],C0,0,0,0),   P0[10],P0[11],P0[12],P0[13], pw1[0]=PKW(P0,8), pw1[1]=PKW(P0,10), pw1); \
    VRD(5); SBAR(); GAPA(C1=__builtin_amdgcn_mfma_f32_32x32x16_bf16(kf[3],qr[1],C1,0,0,0),   P0[14],P0[15],P1[0],P1[1],   pw1[2]=PKW(P0,12),pw1[3]=PKW(P0,14), pw1); \
    VRD(2); SBAR(); GAPA(C0=__builtin_amdgcn_mfma_f32_32x32x16_bf16(kf[4],qr[2],C0,0,0,0),   P1[2],P1[3],P1[4],P1[5],     pw2[0]=PKW(P1,0), pw2[1]=PKW(P1,2), pw2); \
    VRD(6); SBAR(); GAPA(C1=__builtin_amdgcn_mfma_f32_32x32x16_bf16(kf[5],qr[2],C1,0,0,0),   P1[6],P1[7],P1[8],P1[9],     pw2[2]=PKW(P1,4), pw2[3]=PKW(P1,6), pw2); \
    VRD(3); SBAR(); GAPA(C0=__builtin_amdgcn_mfma_f32_32x32x16_bf16(kf[6],qr[3],C0,0,0,0),   P1[10],P1[11],P1[12],P1[13], pw3[0]=PKW(P1,8), pw3[1]=PKW(P1,10), pw3); \
    VRD(7); SBAR(); GAPA(C1=__builtin_amdgcn_mfma_f32_32x32x16_bf16(kf[7],qr[3],C1,0,0,0),   P1[14],P1[15],0.f,0.f,       pw3[2]=PKW(P1,12),pw3[3]=PKW(P1,14), pw3); \
    l_reg+=sacc; \
    if(GK){DMA_K((t)+3,sl_cur);} if(GV){DMA_V((t)+1,sl_next);} \
    CMASK(C0,C1,t); \
    if constexpr(!NOMAX){ float a=MX3(C0[0],C0[1],C1[0]),b=MX3(C0[2],C0[3],C1[1]); a=MX3(a,C1[2],C1[3]); \
      _Pragma("unroll") for(int r=4;r<16;r+=4){a=MX3(a,C0[r],C0[r+1]);b=MX3(b,C0[r+2],C0[r+3]);a=MX3(a,C1[r],C1[r+1]);b=MX3(b,C1[r+2],C1[r+3]);} \
      float rm=__builtin_fmaxf(a,b); { auto rr=__builtin_amdgcn_permlane32_swap(__float_as_uint(rm),__float_as_uint(rm),false,false); rm=__builtin_fmaxf(__uint_as_float(rr[0]),__uint_as_float(rr[1])); } \
      resc=false; \
      if(__builtin_expect(__any(rm>(float)THRL),0)){ const float dl=__builtin_fmaxf(rm,0.f); mhat+=dl; \
        _Pragma("unroll") for(int r=0;r<16;++r){C0[r]-=dl;C1[r]-=dl;} \
        _Pragma("unroll") for(int r=0;r<16;++r)negm[r]=-mhat; asm volatile("":"+v"(negm)); \
        const float f=__builtin_amdgcn_exp2f(-dl); l_reg*=f; if(hi==0)wsf[r32]=f; resc=true; } } \
    SBAR(); \
    GAPB(o[0]=__builtin_amdgcn_mfma_f32_32x32x16_bf16(PAF(0),VFR(0),o[0],0,0,0), C0,0); \
    GAPB(o[1]=__builtin_amdgcn_mfma_f32_32x32x16_bf16(PAF(0),VFR(4),o[1],0,0,0), C0,4); \
    KRD(GL,0); GAPB(o[0]=__builtin_amdgcn_mfma_f32_32x32x16_bf16(PAF(1),VFR(1),o[0],0,0,0), C0,8); \
    KRD(GL,1); GAPB(o[1]=__builtin_amdgcn_mfma_f32_32x32x16_bf16(PAF(1),VFR(5),o[1],0,0,0), C0,12); \
    KRD(GL,2); GAPB(o[0]=__builtin_amdgcn_mfma_f32_32x32x16_bf16(PAF(2),VFR(2),o[0],0,0,0), C1,0); \
    KRD(GL,3); GAPB(o[1]=__builtin_amdgcn_mfma_f32_32x32x16_bf16(PAF(2),VFR(6),o[1],0,0,0), C1,4); \
    GAPB(o[0]=__builtin_amdgcn_mfma_f32_32x32x16_bf16(PAF(3),VFR(3),o[0],0,0,0), C1,8); \
    GAPB(o[1]=__builtin_amdgcn_mfma_f32_32x32x16_bf16(PAF(3),VFR(7),o[1],0,0,0), C1,12); \
    }while(0)
  int t=1;
  #undef CMASK
  #define CMASK(P0,P1,t) do{}while(0)
  for(;t+5<NT;t+=2){
    STEP(pB0,pB1,pA0,pA1,t,true,true,true);     WAIT_BAR(2); RESC(); ROT();
    STEP(pA0,pA1,pB0,pB1,t+1,true,true,true);   WAIT_BAR(2); RESC(); ROT();
  }
  #undef CMASK
  #define CMASK(P0,P1,t) do{}while(0)
  #define ENDW(tt) do{ if((tt)+3<NT){WAIT_BAR(2);} else if((tt)+2<NT){WAIT_BAR(1);} else {WAIT_BAR(0);} }while(0)
  for(;t+1<NT;t+=2){
    STEP(pB0,pB1,pA0,pA1,t,(t+3<NT),(t+1<NT),(t+1<NT));       ENDW(t);   RESC(); ROT();
    STEP(pA0,pA1,pB0,pB1,t+1,(t+4<NT),(t+2<NT),(t+2<NT));     ENDW(t+1); RESC(); ROT();
  }
  STEP(pB0,pB1,pA0,pA1,NT-1,false,false,false); RESC();
  { float sacc=pB0[0]+pB0[1]; _Pragma("unroll") for(int r=2;r<16;++r)sacc+=pB0[r]; _Pragma("unroll") for(int r=0;r<16;++r)sacc+=pB1[r]; l_reg+=sacc;
    pw0=(u32x4){PKW(pB0,0),PKW(pB0,2),PKW(pB0,4),PKW(pB0,6)};pw1=(u32x4){PKW(pB0,8),PKW(pB0,10),PKW(pB0,12),PKW(pB0,14)};pw2=(u32x4){PKW(pB1,0),PKW(pB1,2),PKW(pB1,4),PKW(pB1,6)};pw3=(u32x4){PKW(pB1,8),PKW(pB1,10),PKW(pB1,12),PKW(pB1,14)};
    SBAR(); pv(o,vb0+sl_cur,PAF(0),PAF(1),PAF(2),PAF(3)); }
  #undef PKW
  #undef PAF
  #undef VFR
  #undef PIN
  #undef MX3
  #undef GAPA
  #undef GAPB
  #undef EX
  #undef VRD
  #undef KRD
  #undef STEP
  #undef ENDW
  {auto rr=__builtin_amdgcn_permlane32_swap(__float_as_uint(l_reg),__float_as_uint(l_reg),false,false);l_reg=__uint_as_float(rr[0])+__uint_as_float(rr[1]);}
  if(hi==0)wsf[32+r32]=l_reg;asm volatile("s_waitcnt lgkmcnt(0)":::"memory");
  float rli[16];
  #pragma unroll
  for(int r=0;r<16;++r)rli[r]=__builtin_amdgcn_rcpf(wsf[32+crow(r,hi)]);
  bf16*Ow=O+(long)(row0+wid*QBLK)*OP+hq*D;
  { bf16*stg=(bf16*)(shm+LDS_OST)+wid*2048;
    #pragma unroll
    for(int r=0;r<16;++r){const int orow=crow(r,hi);
      #pragma unroll
      for(int d0=0;d0<2;++d0)stg[orow*64+d0*32+r32]=(bf16)(cvtpk_s(o[d0][r]*rli[r],0.f)&0xffffu);}
    asm volatile("s_waitcnt lgkmcnt(0)":::"memory");
    #pragma unroll
    for(int i=0;i<4;++i){const int row=i*8+(lane>>3),ch=lane&7; const u32x4 v=*(const u32x4*)(stg+row*64+ch*8); ATTN_STORE16(Ow+(long)row*OP+ch*8,v);} }
  asm volatile("s_waitcnt lgkmcnt(0)\n\ts_barrier":::"memory");
  #undef DMA_K
  #undef DMA_V
  #undef CMASK
  #undef START
  #undef RESC
  #undef ROT
}
constexpr int ATTN_LDS_BYTES=LDS_BYTES;
#undef SBAR
#undef WAIT_BAR
}

DEV void ph_attn_fast(const PV& p, const int l, int bid, int nb, unsigned char* smem) {
    const attn_body::bf16* Q = wsp<attn_body::bf16>(p, WS_AQ); const attn_body::bf16* K = wsp<attn_body::bf16>(p, WS_AK); const attn_body::bf16* V = wsp<attn_body::bf16>(p, WS_AV);
    attn_body::bf16* O = wsp<attn_body::bf16>(p, WS_Y) + 512;
    float gq, gk;
    { const int lane = p.tid() & 63; gq = fabsf(p.inp(I_AQG)[l * 64 + lane]); gk = fabsf(p.inp(I_AKG)[l * 64 + lane]);
      gq = fmaxf(gq, SWZ_XOR(gq, 0x041F)); gq = fmaxf(gq, SWZ_XOR(gq, 0x081F)); gq = fmaxf(gq, SWZ_XOR(gq, 0x101F)); gq = fmaxf(gq, SWZ_XOR(gq, 0x201F)); gq = fmaxf(gq, SWZ_XOR(gq, 0x401F));
      gk = fmaxf(gk, SWZ_XOR(gk, 0x041F)); gk = fmaxf(gk, SWZ_XOR(gk, 0x081F)); gk = fmaxf(gk, SWZ_XOR(gk, 0x101F)); gk = fmaxf(gk, SWZ_XOR(gk, 0x201F)); gk = fmaxf(gk, SWZ_XOR(gk, 0x401F));
      gq = fmaxf(RL(gq, 0), RL(gq, 32)); gk = fmaxf(RL(gk, 0), RL(gk, 32)); }
    const float bound = 64.f * attn_body::C2 * gq * gk * 1.05f;
    const bool nomax = bound <= 40.f;
    if (nomax) {
        for (int u = bid; u < 256; u += nb) { const int x = u & 7, hq = x >> 1, qb = (u >> 3) + 32 * (x & 1); attn_body::attn_unit<8, true>(hq, NC + 256 * qb, T / 64, Q, K, V, O, (char*)smem, p.z, p.tid()); }
        if (l == 0) for (int u = bid; u < 4; u += nb) attn_body::attn_unit<8, true>(u, 0, NC / 64, Q, K, V, O, (char*)smem, p.z, p.tid());
    } else {
        for (int u = bid; u < 256; u += nb) { const int x = u & 7, hq = x >> 1, qb = (u >> 3) + 32 * (x & 1); attn_body::attn_unit<8>(hq, NC + 256 * qb, T / 64, Q, K, V, O, (char*)smem, p.z, p.tid()); }
        if (l == 0) for (int u = bid; u < 4; u += nb) attn_body::attn_unit<8>(u, 0, NC / 64, Q, K, V, O, (char*)smem, p.z, p.tid());
    }
}

namespace mx {
using pg::cvt_pk_bf16;
typedef short bf16x8 __attribute__((ext_vector_type(8), may_alias));
typedef unsigned u32x4 __attribute__((ext_vector_type(4), may_alias));
typedef unsigned u32x2 __attribute__((ext_vector_type(2), may_alias));
constexpr int TS = 144, TILE_B = 64 * TS, WAVE_LDS = 2 * TILE_B + 1024;
constexpr int NCH = 260;
constexpr size_t WS_DSR = 191 * MiB, WS_SSR = 224 * MiB;
DEV int chunk_base(int dir, int s) { if (s < 4) return 64 * (dir ? 3 - s : s); const int ns = s - 4; return NC + 64 * (dir ? 255 - ns : ns); }
DEV int scan_index(int dir, int cn) { if (cn < 4) return dir ? 3 - cn : cn; const int c = cn - 4; return 4 + (dir ? 255 - c : c); }

template <bool INIT = false> DEV void mm64(f32x4 (&acc)[4][4], LAS const unsigned char* A, LAS const unsigned char* B, int lane) {
    const int r = lane & 15, q = lane >> 4;
#pragma unroll
    for (int ks = 0; ks < 2; ++ks) {
        bf16x8 a[4], b[4];
#pragma unroll
        for (int t = 0; t < 4; ++t) { a[t] = *(const LAS bf16x8*)(A + (16 * t + r) * TS + ks * 64 + q * 16); b[t] = *(const LAS bf16x8*)(B + (16 * t + r) * TS + ks * 64 + q * 16); }
#pragma unroll
        for (int mt = 0; mt < 4; ++mt)
#pragma unroll
            for (int nt = 0; nt < 4; ++nt) acc[mt][nt] = __builtin_amdgcn_mfma_f32_16x16x32_bf16(a[mt], b[nt], (INIT && ks == 0) ? (f32x4){0.f, 0.f, 0.f, 0.f} : acc[mt][nt], 0, 0, 0);
    }
}
template <bool INIT = false> DEV void mm32(f32x4 (&acc)[2][4], LAS const unsigned char* A, LAS const unsigned char* B, int lane, int mh) {
    const int r = lane & 15, q = lane >> 4;
#pragma unroll
    for (int ks = 0; ks < 2; ++ks) {
        bf16x8 a[2], b[4];
#pragma unroll
        for (int t = 0; t < 2; ++t) a[t] = *(const LAS bf16x8*)(A + (32 * mh + 16 * t + r) * TS + ks * 64 + q * 16);
#pragma unroll
        for (int t = 0; t < 4; ++t) b[t] = *(const LAS bf16x8*)(B + (16 * t + r) * TS + ks * 64 + q * 16);
#pragma unroll
        for (int mt = 0; mt < 2; ++mt)
#pragma unroll
            for (int nt = 0; nt < 4; ++nt) acc[mt][nt] = __builtin_amdgcn_mfma_f32_16x16x32_bf16(a[mt], b[nt], (INIT && ks == 0) ? (f32x4){0.f, 0.f, 0.f, 0.f} : acc[mt][nt], 0, 0, 0);
    }
}
DEV void zero_acc(f32x4 (&acc)[4][4], float zf) {
#pragma unroll
    for (int a = 0; a < 4; ++a)
#pragma unroll
        for (int b = 0; b < 4; ++b) acc[a][b] = (f32x4){zf, zf, zf, zf};
}
DEV void acc_to_tile_T(const f32x4 (&acc)[4][4], LAS unsigned char* tile, int lane) {
    const int r = lane & 15, q = lane >> 4;
#pragma unroll
    for (int mt = 0; mt < 4; ++mt)
#pragma unroll
        for (int nt = 0; nt < 4; ++nt) { u32x2 w; w.x = cvt_pk_bf16(acc[mt][nt][0], acc[mt][nt][1]); w.y = cvt_pk_bf16(acc[mt][nt][2], acc[mt][nt][3]);
            *(LAS u32x2*)(tile + (16 * nt + r) * TS + (16 * mt + 4 * q) * 2) = w; }
}
template <class F> DEV void stage_T(LAS unsigned char* tile, int lane, const F& f) {
#pragma unroll 1
    for (int hh = 0; hh < 2; ++hh) {
        unsigned pk[16];
#pragma unroll
        for (int i = 0; i < 32; i += 2) pk[i >> 1] = cvt_pk_bf16(f(hh * 32 + i), f(hh * 32 + i + 1));
#pragma unroll
        for (int c = 0; c < 4; ++c) { u32x4 w; w.x = pk[4 * c]; w.y = pk[4 * c + 1]; w.z = pk[4 * c + 2]; w.w = pk[4 * c + 3]; *(LAS u32x4*)(tile + lane * TS + hh * 64 + c * 16) = w; }
    }
}
DEV void stage_copy(LAS unsigned char* tile, int lane, const bf16_t* src) {
    u32x4 w[8];
#pragma unroll
    for (int c = 0; c < 8; ++c) w[c] = *(const u32x4*)(src + c * 8);
#pragma unroll
    for (int c = 0; c < 8; ++c) *(LAS u32x4*)(tile + lane * TS + c * 16) = w[c];
}
typedef unsigned short u16a __attribute__((may_alias));
template <bool DESC, class F> DEV void transpose_inplace(LAS unsigned char* tile, int lane, F& f) {
    unsigned raw[32];
#pragma unroll
    for (int i = 0; i < 64; i += 2) raw[i >> 1] = (unsigned)*(const LAS u16a*)(tile + i * TS + lane * 2) | ((unsigned)*(const LAS u16a*)(tile + (i + 1) * TS + lane * 2) << 16);
    if constexpr (!DESC) {
#pragma unroll
        for (int i = 0; i < 64; i += 2) { const float lo = f(i, __uint_as_float(raw[i >> 1] << 16)); const float hi = f(i + 1, __uint_as_float(raw[i >> 1] & 0xffff0000u)); raw[i >> 1] = cvt_pk_bf16(lo, hi); }
    } else {
#pragma unroll
        for (int i = 62; i >= 0; i -= 2) { const float hi = f(i + 1, __uint_as_float(raw[i >> 1] & 0xffff0000u)); const float lo = f(i, __uint_as_float(raw[i >> 1] << 16)); raw[i >> 1] = cvt_pk_bf16(lo, hi); }
    }
#pragma unroll
    for (int c = 0; c < 8; ++c) { u32x4 w; w.x = raw[4 * c]; w.y = raw[4 * c + 1]; w.z = raw[4 * c + 2]; w.w = raw[4 * c + 3]; *(LAS u32x4*)(tile + lane * TS + c * 16) = w; }
}
DEV void stage_rope(LAS unsigned char* tile, int lane, const bf16_t* src, int row, const float* RC, float scale) {
    float v[64];
#pragma unroll
    for (int c = 0; c < 8; ++c) { const u32x4 w = *(const u32x4*)(src + c * 8);
        v[8 * c] = __uint_as_float(w.x << 16); v[8 * c + 1] = __uint_as_float(w.x & 0xffff0000u); v[8 * c + 2] = __uint_as_float(w.y << 16); v[8 * c + 3] = __uint_as_float(w.y & 0xffff0000u);
        v[8 * c + 4] = __uint_as_float(w.z << 16); v[8 * c + 5] = __uint_as_float(w.z & 0xffff0000u); v[8 * c + 6] = __uint_as_float(w.w << 16); v[8 * c + 7] = __uint_as_float(w.w & 0xffff0000u); }
    {
        const int tl = row >= NC ? row - NC : 0;
#pragma unroll
        for (int a = 0; a < 2; ++a) { const int pos = a ? (tl & 63) : (tl >> 6);
#pragma unroll
            for (int j = 0; j < 16; ++j) { const float c = RC[pos * 16 + j], sn = RC[4096 + pos * 16 + j], x1 = v[a * 32 + j], x2 = v[a * 32 + 16 + j]; v[a * 32 + j] = x1 * c - x2 * sn; v[a * 32 + 16 + j] = x2 * c + x1 * sn; } }
    }
#pragma unroll
    for (int c = 0; c < 8; ++c) { u32x4 w; w.x = cvt_pk_bf16(v[8 * c] * scale, v[8 * c + 1] * scale); w.y = cvt_pk_bf16(v[8 * c + 2] * scale, v[8 * c + 3] * scale);
        w.z = cvt_pk_bf16(v[8 * c + 4] * scale, v[8 * c + 5] * scale); w.w = cvt_pk_bf16(v[8 * c + 6] * scale, v[8 * c + 7] * scale); *(LAS u32x4*)(tile + lane * TS + c * 16) = w; }
}
DEV int relane() { unsigned z; asm volatile("s_mov_b32 %0, 0" : "=s"(z)); return (int)__builtin_amdgcn_mbcnt_hi(~0u, __builtin_amdgcn_mbcnt_lo(~0u, z)); }
DEV float dpp_row_mirror(float x) { return __int_as_float(__builtin_amdgcn_update_dpp(0, __float_as_int(x), 0x140, 0xf, 0xf, true)); }

DEV void head_out(const PV& p, const float* gn, const f32x4 (&tot)[4][4], int nbase, int zgate, int ycol, int lane) {
    asm volatile("" : "+v"(lane));
    const bf16_t* Z = wsp<bf16_t>(p, WS_Z); bf16_t* Y = wsp<bf16_t>(p, WS_Y); const int r = lane & 15, q = lane >> 4;
#pragma unroll
    for (int nt = 0; nt < 4; ++nt) {
        float ss = 0.f;
#pragma unroll
        for (int mt = 0; mt < 4; ++mt) ss += tot[mt][nt][0] * tot[mt][nt][0] + tot[mt][nt][1] * tot[mt][nt][1] + tot[mt][nt][2] * tot[mt][nt][2] + tot[mt][nt][3] * tot[mt][nt][3];
        ss += SWZ_XOR(ss, 0x401F);
        { const auto rr = __builtin_amdgcn_permlane32_swap(__float_as_uint(ss), __float_as_uint(ss), false, false); ss = __uint_as_float(rr[0]) + __uint_as_float(rr[1]); }
        const float rs = rsqrtf(ss * (1.f / 64.f) + EPS);
        const int row = nbase + 16 * nt + r;
#pragma unroll
        for (int mt = 0; mt < 4; ++mt) { const int v0 = 16 * mt + 4 * q; const f32x4 g4 = *(const f32x4*)(gn + v0);
            const u32x2 gz = *(const u32x2*)(Z + (size_t)row * ZW + zgate + v0);
            const float z0 = __uint_as_float(gz.x << 16), z1 = __uint_as_float(gz.x & 0xffff0000u), z2 = __uint_as_float(gz.y << 16), z3 = __uint_as_float(gz.y & 0xffff0000u);
            u32x2 w; w.x = cvt_pk_bf16(tot[mt][nt][0] * rs * g4.x * z0 * pg::fsigm(z0), tot[mt][nt][1] * rs * g4.y * z1 * pg::fsigm(z1));
            w.y = cvt_pk_bf16(tot[mt][nt][2] * rs * g4.z * z2 * pg::fsigm(z2), tot[mt][nt][3] * rs * g4.w * z3 * pg::fsigm(z3));
            *(u32x2*)(Y + (size_t)row * 1024 + ycol + v0) = w; }
    }
}
DEV float ex2(float x) { return __builtin_amdgcn_exp2f(x); }
DEV float ret_lg2(int dir, int h) { const int hh = dir ? 3 - h : h; return __builtin_amdgcn_logf(1.f - ex2(-5.f - (float)hh)); }
DEV void ret_x1(const PV& p, int dir, int h, int s, LAS unsigned char* wl, int lane) {
    asm volatile("" : "+v"(lane));
    const bf16_t* Z = wsp<bf16_t>(p, WS_Z); const float* RC = wsp<float>(p, WS_ROPE);
    const int base = chunk_base(dir, s); const bool lat = base >= NC; const float lg2 = ret_lg2(dir, h);
    LAS unsigned char* t0 = wl; LAS unsigned char* t1 = wl + TILE_B;
    const int row_l = base + (dir ? 63 - lane : lane);
    stage_copy(t0, lane, Z + (size_t)row_l * ZW + ZC_RK + h * 64);
    stage_copy(t1, lane, Z + (size_t)row_l * ZW + ZC_RV + h * 64);
    { auto fk = [&](int i, float x) { const int row = base + (dir ? 63 - i : i);
          const int tl = lat ? row - NC : 0, pos = (lane >= 32) ? (tl & 63) : (tl >> 6), j = lane & 15; const float c = RC[pos * 16 + j], sn = RC[4096 + pos * 16 + j]; const float xp = SWZ_XOR(x, 0x401F);
          x = (lane & 16) ? x * c + xp * sn : x * c - xp * sn;
          return x * 0.125f * ex2((float)(63 - i) * lg2); };
      transpose_inplace<false>(t0, lane, fk); }
    { auto fv = [&](int i, float x) { return x; }; transpose_inplace<false>(t1, lane, fv); }
    f32x4 acc[4][4];
    mm64<true>(acc, t0, t1, lane);
    float* DS = wsp<float>(p, WS_DSR) + ((size_t)(dir * 4 + h) * NCH + s) * 4096;
    const int r = lane & 15, q = lane >> 4;
#pragma unroll
    for (int mt = 0; mt < 4; ++mt)
#pragma unroll
        for (int nt = 0; nt < 4; ++nt) *(f32x4*)(DS + (16 * nt + r) * 64 + 16 * mt + 4 * q) = acc[mt][nt];
}
DEV void ret_x2(const PV& p, int gt) {
    const int chain = gt >> 12, e = gt & 4095; const float decay = ex2(64.f * ret_lg2(chain >> 2, chain & 3));
    const float* DS = wsp<float>(p, WS_DSR) + (size_t)chain * NCH * 4096 + e; bf16_t* SS = wsp<bf16_t>(p, WS_SSR) + (size_t)chain * NCH * 4096 + e;
    float S = __uint_as_float(p.z);
    for (int s0 = 0; s0 < NCH; s0 += 52) { float d[52];
#pragma unroll
        for (int k = 0; k < 52; ++k) d[k] = DS[(size_t)(s0 + k) * 4096];
#pragma unroll
        for (int k = 0; k < 52; ++k) { SS[(size_t)(s0 + k) * 4096] = f2bf(S); S = decay * S + d[k]; } }
}
DEV void ret_x3(const PV& p, const int l, int h, int cn, LAS unsigned char* wl, int lane) {
    asm volatile("" : "+v"(lane));
    const bf16_t* Z = wsp<bf16_t>(p, WS_Z); const float* RC = wsp<float>(p, WS_ROPE); const float zf = __uint_as_float(p.z);
    const int nbase = cn < 4 ? 64 * cn : NC + 64 * (cn - 4); const int r = lane & 15, q = lane >> 4;
    LAS unsigned char* t0 = wl; LAS unsigned char* t1 = wl + TILE_B;
    const float lgf = ret_lg2(0, h), lgb = ret_lg2(1, h);
    const int row_l = nbase + lane;
    stage_rope(t0, lane, Z + (size_t)row_l * ZW + ZC_RK + h * 64, row_l, RC, 0.125f);
    stage_rope(t1, lane, Z + (size_t)row_l * ZW + ZC_RQ + h * 64, row_l, RC, 1.f);
    unsigned pk[4][4][2];
    { f32x4 accP[4][4]; mm64<true>(accP, t0, t1, lane);
#pragma unroll
      for (int mt = 0; mt < 4; ++mt)
#pragma unroll
        for (int nt = 0; nt < 4; ++nt) { float e[4];
#pragma unroll
            for (int g = 0; g < 4; ++g) { const int jj = 16 * mt + 4 * q + g, ii = 16 * nt + r;
                const int dd = ii - jj; float f = ex2((float)(dd > 0 ? dd : -dd) * (dd > 0 ? lgf : lgb)); f = dd == 0 ? 2.f : f; e[g] = accP[mt][nt][g] * f; }
            pk[mt][nt][0] = cvt_pk_bf16(e[0], e[1]); pk[mt][nt][1] = cvt_pk_bf16(e[2], e[3]); } }
    f32x4 tot[4][4];

    stage_copy(t0, lane, wsp<bf16_t>(p, WS_SSR) + ((size_t)(0 * 4 + h) * NCH + scan_index(0, cn)) * 4096 + lane * 64);
    mm64<true>(tot, t0, t1, lane);
#pragma unroll
    for (int nt = 0; nt < 4; ++nt) { const float f = ex2((float)(16 * nt + r + 1) * lgf);
#pragma unroll
        for (int mt = 0; mt < 4; ++mt) tot[mt][nt] *= f; }
    stage_copy(t0, lane, wsp<bf16_t>(p, WS_SSR) + ((size_t)(1 * 4 + h) * NCH + scan_index(1, cn)) * 4096 + lane * 64);
    { f32x4 accB[4][4]; mm64<true>(accB, t0, t1, lane);
#pragma unroll
      for (int nt = 0; nt < 4; ++nt) { const float f = ex2((float)(64 - 16 * nt - r) * lgb);
#pragma unroll
          for (int mt = 0; mt < 4; ++mt) tot[mt][nt] += accB[mt][nt] * f; } }
#pragma unroll
    for (int mt = 0; mt < 4; ++mt)
#pragma unroll
        for (int nt = 0; nt < 4; ++nt) { u32x2 w; w.x = pk[mt][nt][0]; w.y = pk[mt][nt][1]; *(LAS u32x2*)(t0 + (16 * nt + r) * TS + (16 * mt + 4 * q) * 2) = w; }
    stage_copy(t1, lane, Z + (size_t)row_l * ZW + ZC_RV + h * 64);
    { auto fv = [&](int i, float x) { return x; }; transpose_inplace<false>(t1, lane, fv); }
    mm64(tot, t1, t0, lane);
    head_out(p, p.inp(I_RNG) + l * 64, tot, nbase, ZC_RG + h * 64, h * 64, lane);
}

constexpr size_t WS_DSH = 505 * MiB, WS_SSH = 554 * MiB, WS_ACH = WS_SSH + 17 * MiB;
template <class F> DEV void stage_T_desc(LAS unsigned char* tile, int lane, F& f) {
#pragma unroll 1
    for (int hh = 1; hh >= 0; --hh) {
        unsigned pk[16];
#pragma unroll
        for (int i = 30; i >= 0; i -= 2) { const float hi = f(hh * 32 + i + 1); const float lo = f(hh * 32 + i); pk[i >> 1] = cvt_pk_bf16(lo, hi); }
#pragma unroll
        for (int c = 0; c < 4; ++c) { u32x4 w; w.x = pk[4 * c]; w.y = pk[4 * c + 1]; w.z = pk[4 * c + 2]; w.w = pk[4 * c + 3]; *(LAS u32x4*)(tile + lane * TS + hh * 64 + c * 16) = w; }
    }
}
DEV void hg_x1(const PV& p, const int l, int dir, int h, int s, LAS unsigned char* wl, int lane) {
    asm volatile("" : "+v"(lane));
    const bf16_t* Z = wsp<bf16_t>(p, WS_Z);
    const int base = chunk_base(dir, s), zc = (dir ? ZC_HFB : ZC_HFF) + h * 64 + lane;
    const float lb = wsp<float>(p, WS_LB)[(dir * 2 + l) * 256 + h * 64 + lane];
    LAS unsigned char* t0 = wl; LAS unsigned char* t1 = wl + TILE_B;
    const int row_l = base + (dir ? 63 - lane : lane);
    stage_copy(t0, lane, Z + (size_t)row_l * ZW + (dir ? ZC_HFB : ZC_HFF) + h * 64);
    stage_copy(t1, lane, Z + (size_t)row_l * ZW + ZC_HI + h * 64);
    float w = __uint_as_float(p.z);
    auto fk = [&](int i, float z) { const float f = lb + (1.f - lb) * pg::fsigm(z), k = (1.f - lb) * pg::fsigm(-z); const float val = k * ex2(w); w += __builtin_amdgcn_logf(f); return val; };
    transpose_inplace<true>(t0, lane, fk);
    const int chain = dir * 4 + h;
    wsp<float>(p, WS_ACH)[((size_t)chain * NCH + s) * 64 + lane] = ex2(w);
    { auto fv = [&](int i, float x) { return x; }; transpose_inplace<false>(t1, lane, fv); }
    f32x4 acc[4][4];
    mm64<true>(acc, t0, t1, lane);
    float* DS = wsp<float>(p, WS_DSH) + ((size_t)chain * NCH + s) * 4096;
    const int r = lane & 15, q = lane >> 4;
#pragma unroll
    for (int mt = 0; mt < 4; ++mt)
#pragma unroll
        for (int nt = 0; nt < 4; ++nt) *(f32x4*)(DS + (16 * nt + r) * 64 + 16 * mt + 4 * q) = acc[mt][nt];
}
DEV void hg_x2(const PV& p, int gt) {
    const int chain = gt >> 12, e = gt & 4095, d = e & 63;
    const float* DS = wsp<float>(p, WS_DSH) + (size_t)chain * NCH * 4096 + e; bf16_t* SS = wsp<bf16_t>(p, WS_SSH) + (size_t)chain * NCH * 4096 + e;
    const float* AC = wsp<float>(p, WS_ACH) + (size_t)chain * NCH * 64 + d;
    float S = __uint_as_float(p.z);
    for (int s0 = 0; s0 < NCH; s0 += 52) { float dd[52], aa[52];
#pragma unroll
        for (int k = 0; k < 52; ++k) { dd[k] = DS[(size_t)(s0 + k) * 4096]; aa[k] = AC[(s0 + k) * 64]; }
#pragma unroll
        for (int k = 0; k < 52; ++k) { SS[(size_t)(s0 + k) * 4096] = f2bf(S); S = aa[k] * S + dd[k]; } }
}
DEV void hg_x3(const PV& p, const int l, int h, int cn, LAS unsigned char* wl, int lane, float* park  ) {
    asm volatile("" : "+v"(lane));
    const bf16_t* Z = wsp<bf16_t>(p, WS_Z); const float zf = __uint_as_float(p.z);
    const int nbase = cn < 4 ? 64 * cn : NC + 64 * (cn - 4); const int r = lane & 15, q = lane >> 4;
    LAS unsigned char* t0 = wl; LAS unsigned char* t1 = wl + TILE_B; LAS float* misc = (LAS float*)(wl + 2 * TILE_B);
    f32x4 tot[4][4];
    unsigned pk[4][4][2];
    auto stageQK = [&](const int dir) {
        const float lb = wsp<float>(p, WS_LB)[(dir * 2 + l) * 256 + h * 64 + lane];
        stage_copy(t0, lane, Z + (size_t)(nbase + lane) * ZW + (dir ? ZC_HFB : ZC_HFF) + h * 64);
        stage_copy(t1, lane, Z + (size_t)(nbase + lane) * ZW + ZC_HQ + h * 64);
        float w = zf;
#pragma unroll 4
        for (int ip = 31; ip >= 0; --ip) { const int i = dir ? 63 - ip : ip;
            const float z = bf2f(*(const LAS u16a*)(t0 + i * TS + lane * 2)), zq = bf2f(*(const LAS u16a*)(t1 + i * TS + lane * 2));
            const float f = lb + (1.f - lb) * pg::fsigm(z), k = (1.f - lb) * pg::fsigm(-z), qq = zq * pg::fsigm(zq);
            *(LAS u16a*)(t0 + i * TS + lane * 2) = f2bf(k * ex2(w)); *(LAS u16a*)(t1 + i * TS + lane * 2) = f2bf(qq * ex2(-w));
            w += __builtin_amdgcn_logf(f); }
        misc[lane] = ex2(w);
        float w2 = zf;
#pragma unroll 4
        for (int ip = 32; ip < 64; ++ip) { const int i = dir ? 63 - ip : ip;
            const float z = bf2f(*(const LAS u16a*)(t0 + i * TS + lane * 2)), zq = bf2f(*(const LAS u16a*)(t1 + i * TS + lane * 2));
            const float f = lb + (1.f - lb) * pg::fsigm(z), k = (1.f - lb) * pg::fsigm(-z), qq = zq * pg::fsigm(zq);
            w2 += __builtin_amdgcn_logf(f);
            *(LAS u16a*)(t0 + i * TS + lane * 2) = f2bf(k * ex2(-w2)); *(LAS u16a*)(t1 + i * TS + lane * 2) = f2bf(qq * ex2(w2)); }
    };
    auto inter = [&](const int dir) {
        const bf16_t* src = wsp<bf16_t>(p, WS_SSH) + ((size_t)(dir * 4 + h) * NCH + scan_index(dir, cn)) * 4096 + lane * 64;
#pragma unroll
        for (int c8 = 0; c8 < 8; ++c8) { const pg::u32x4 w = *(const pg::u32x4*)(src + c8 * 8); const f32x4 e0 = *(const LAS f32x4*)(misc + c8 * 8), e1 = *(const LAS f32x4*)(misc + c8 * 8 + 4);
            u32x4 o; o.x = cvt_pk_bf16(__uint_as_float(w.x << 16) * e0.x, __uint_as_float(w.x & 0xffff0000u) * e0.y); o.y = cvt_pk_bf16(__uint_as_float(w.y << 16) * e0.z, __uint_as_float(w.y & 0xffff0000u) * e0.w);
            o.z = cvt_pk_bf16(__uint_as_float(w.z << 16) * e1.x, __uint_as_float(w.z & 0xffff0000u) * e1.y); o.w = cvt_pk_bf16(__uint_as_float(w.w << 16) * e1.z, __uint_as_float(w.w & 0xffff0000u) * e1.w);
            *(LAS u32x4*)(t0 + lane * TS + c8 * 16) = o; }
        mm64<true>(tot, t0, t1, lane);
    };
    stageQK(0);
    lane = relane();
#pragma unroll
    for (int mh = 0; mh < 2; ++mh) { f32x4 accP[2][4];
      mm32<true>(accP, t0, t1, lane, mh);
#pragma unroll
      for (int m2 = 0; m2 < 2; ++m2)
#pragma unroll
        for (int nt = 0; nt < 4; ++nt) { const int mt = 2 * mh + m2; float e[4];
#pragma unroll
            for (int g = 0; g < 4; ++g) { const int jj = 16 * mt + 4 * q + g, ii = 16 * nt + r; e[g] = jj <= ii ? accP[m2][nt][g] : 0.f; }
            pk[mt][nt][0] = cvt_pk_bf16(e[0], e[1]); pk[mt][nt][1] = cvt_pk_bf16(e[2], e[3]); } }
    lane = relane();
    inter(0);
    { float* pl = park + lane * 64;
#pragma unroll
      for (int mt = 0; mt < 4; ++mt)
#pragma unroll
        for (int nt = 0; nt < 4; ++nt) *(f32x4*)(pl + (mt * 4 + nt) * 4) = tot[mt][nt]; }
    lane = relane();
    stageQK(1);
    lane = relane();
#pragma unroll
    for (int mh = 0; mh < 2; ++mh) { f32x4 accP[2][4];
      mm32<true>(accP, t0, t1, lane, mh);
#pragma unroll
      for (int m2 = 0; m2 < 2; ++m2)
#pragma unroll
        for (int nt = 0; nt < 4; ++nt) { const int mt = 2 * mh + m2; float e[4];
            e[0] = __uint_as_float(pk[mt][nt][0] << 16); e[1] = __uint_as_float(pk[mt][nt][0] & 0xffff0000u); e[2] = __uint_as_float(pk[mt][nt][1] << 16); e[3] = __uint_as_float(pk[mt][nt][1] & 0xffff0000u);
#pragma unroll
            for (int g = 0; g < 4; ++g) { const int jj = 16 * mt + 4 * q + g, ii = 16 * nt + r; e[g] += jj >= ii ? accP[m2][nt][g] : 0.f; }
            pk[mt][nt][0] = cvt_pk_bf16(e[0], e[1]); pk[mt][nt][1] = cvt_pk_bf16(e[2], e[3]); } }
    lane = relane();
    inter(1);
    lane = relane();
#pragma unroll
    for (int mt = 0; mt < 4; ++mt)
#pragma unroll
        for (int nt = 0; nt < 4; ++nt) { u32x2 w; w.x = pk[mt][nt][0]; w.y = pk[mt][nt][1]; *(LAS u32x2*)(t0 + (16 * nt + r) * TS + (16 * mt + 4 * q) * 2) = w; }
    stage_copy(t1, lane, Z + (size_t)(nbase + lane) * ZW + ZC_HI + h * 64);
    { auto fv = [&](int i, float x) { return x; }; transpose_inplace<false>(t1, lane, fv); }
    mm64(tot, t1, t0, lane);
    { const float* pp = park + lane * 64; asm volatile("" : "+v"(pp) : "v"(tot[3][3][3]));
#pragma unroll
      for (int mt = 0; mt < 4; ++mt)
#pragma unroll
        for (int nt = 0; nt < 4; ++nt) tot[mt][nt] += *(const f32x4*)(pp + (mt * 4 + nt) * 4); }
    head_out(p, p.inp(I_HNG) + l * 64, tot, nbase, ZC_HG + h * 64, 256 + h * 64, lane);
}
constexpr size_t WS_PARK2 = 191 * MiB;
constexpr size_t WS_PARK = 191 * MiB;
constexpr size_t WS_MCG = 409 * MiB, WS_BCG = 426 * MiB, WS_UTG = 459 * MiB, WS_WNG = 476 * MiB, WS_CGG = 493 * MiB, WS_SSG = 537 * MiB + 512 * 1024;
template <int I> DEV void solve_rows(float (&x)[64], LAS const unsigned char* At) {
    if constexpr (I < 64) {
        float a[4] = {x[I], 0.f, 0.f, 0.f};
        int dep = 0;
        if constexpr (I >= 6) asm("v_and_b32 %0, 0, %1" : "=v"(dep) : "v"(x[I - 6]));
#pragma unroll
        for (int m8 = 0; m8 < (I + 7) / 8; ++m8) { const u32x4 w = *(const LAS u32x4*)(At + I * TS + dep + m8 * 16);
            const float a0 = __uint_as_float(w.x << 16), a1 = __uint_as_float(w.x & 0xffff0000u), a2 = __uint_as_float(w.y << 16), a3 = __uint_as_float(w.y & 0xffff0000u),
                        a4 = __uint_as_float(w.z << 16), a5 = __uint_as_float(w.z & 0xffff0000u), a6 = __uint_as_float(w.w << 16), a7 = __uint_as_float(w.w & 0xffff0000u);
            if (m8 * 8 + 0 < I) a[0] -= a0 * x[m8 * 8 + 0]; if (m8 * 8 + 1 < I) a[1] -= a1 * x[m8 * 8 + 1]; if (m8 * 8 + 2 < I) a[2] -= a2 * x[m8 * 8 + 2]; if (m8 * 8 + 3 < I) a[3] -= a3 * x[m8 * 8 + 3];
            if (m8 * 8 + 4 < I) a[0] -= a4 * x[m8 * 8 + 4]; if (m8 * 8 + 5 < I) a[1] -= a5 * x[m8 * 8 + 5]; if (m8 * 8 + 6 < I) a[2] -= a6 * x[m8 * 8 + 6]; if (m8 * 8 + 7 < I) a[3] -= a7 * x[m8 * 8 + 7]; }
        x[I] = (a[0] + a[1]) + (a[2] + a[3]);
        solve_rows<I + 1>(x, At);
    }
}
typedef float f32x2_t __attribute__((ext_vector_type(2)));
constexpr int tri_off(int i) { return 4 * ((i >> 2) + 1) * (2 * (i >> 2) + (i & 3)); }
static_assert(tri_off(63) + 64 <= TILE_B / 4, "packed triangle fits a tile region");
template <int I> DEV void solve2_rows(f32x2_t (&x)[64], LAS const float* At) {
    if constexpr (I < 64) {
        f32x2_t a0 = x[I], a1 = {0.f, 0.f}, a2 = {0.f, 0.f}, a3 = {0.f, 0.f};
        int dep = 0;
        if constexpr (I >= 24) asm("v_and_b32 %0, 0, %1" : "=v"(dep) : "v"(x[I - 1].x));
        else if constexpr (I >= 3) asm("v_and_b32 %0, 0, %1" : "=v"(dep) : "v"(x[I - 3].x));
        LAS const float* row = At + tri_off(I) + dep;
#pragma unroll
        for (int m4 = 0; m4 < (I + 3) / 4; ++m4) { const f32x4 w = *(const LAS f32x4*)(row + 4 * m4);
            if (4 * m4 + 0 < I) a0 -= w.x * x[4 * m4 + 0]; if (4 * m4 + 1 < I) a1 -= w.y * x[4 * m4 + 1]; if (4 * m4 + 2 < I) a2 -= w.z * x[4 * m4 + 2]; if (4 * m4 + 3 < I) a3 -= w.w * x[4 * m4 + 3]; }
        x[I] = (a0 + a1) + (a2 + a3);
        solve2_rows<I + 1>(x, At);
    }
}
template <int I> DEV void solve2b_rows(f32x2_t (&x)[64], LAS const unsigned char* At) {
    if constexpr (I < 64) {
        f32x2_t a0 = x[I], a1 = {0.f, 0.f}, a2 = {0.f, 0.f}, a3 = {0.f, 0.f};
        int dep = 0;
        if constexpr (I >= 3) asm("v_and_b32 %0, 0, %1" : "=v"(dep) : "v"(x[I - 3].x));
#pragma unroll
        for (int m8 = 0; m8 < (I + 7) / 8; ++m8) { const u32x4 w = *(const LAS u32x4*)(At + I * TS + dep + m8 * 16);
            const float e0 = __uint_as_float(w.x << 16), e1 = __uint_as_float(w.x & 0xffff0000u), e2 = __uint_as_float(w.y << 16), e3 = __uint_as_float(w.y & 0xffff0000u),
                        e4 = __uint_as_float(w.z << 16), e5 = __uint_as_float(w.z & 0xffff0000u), e6 = __uint_as_float(w.w << 16), e7 = __uint_as_float(w.w & 0xffff0000u);
            if (m8 * 8 + 0 < I) a0 -= e0 * x[m8 * 8 + 0]; if (m8 * 8 + 1 < I) a1 -= e1 * x[m8 * 8 + 1]; if (m8 * 8 + 2 < I) a2 -= e2 * x[m8 * 8 + 2]; if (m8 * 8 + 3 < I) a3 -= e3 * x[m8 * 8 + 3];
            if (m8 * 8 + 4 < I) a0 -= e4 * x[m8 * 8 + 4]; if (m8 * 8 + 5 < I) a1 -= e5 * x[m8 * 8 + 5]; if (m8 * 8 + 6 < I) a2 -= e6 * x[m8 * 8 + 6]; if (m8 * 8 + 7 < I) a3 -= e7 * x[m8 * 8 + 7]; }
        x[I] = (a0 + a1) + (a2 + a3);
        solve2b_rows<I + 1>(x, At);
    }
}
template <int dir> DEV void gdn_x1(const PV& p, const int l, int h, int s, LAS unsigned char* wl, int lane) {
    asm volatile("" : "+v"(lane));
    const float zf = __uint_as_float(p.z);
    const bf16_t* GQ = wsp<bf16_t>(p, WS_GQKV); const float* GATE = wsp<float>(p, WS_GATE);
    const int base = chunk_base(dir, s), chain = dir * 4 + h; const size_t unit = (size_t)chain * NCH + s;
    const int r = lane & 15, q = lane >> 4;
    LAS unsigned char* t0 = wl; LAS unsigned char* t1 = wl + TILE_B; LAS float* misc = (LAS float*)(wl + 2 * TILE_B);
    const int row_l = base + (dir ? 63 - lane : lane);
    {
        const float Aexp = ex2(p.inp(I_ALOG)[(l * 2 + dir) * 4 + h] * 1.4426950408889634f), dtb = p.inp(I_DTB)[(l * 2 + dir) * 4 + h];
        const float av = GATE[(size_t)row_l * 16 + dir * 4 + h] + dtb, bv = GATE[(size_t)row_l * 16 + 8 + dir * 4 + h];
        const float ey = ex2(av * 1.4426950408889634f);
        const float sp = av > 20.f ? av : (ey < 0.01f ? ey * (1.f - ey * (0.5f - ey * (1.f / 3.f))) : __builtin_amdgcn_logf(1.f + ey) * 0.6931471805599453f);
        const float g2 = -Aexp * sp * 1.4426950408889634f;
        misc[128 + lane] = g2; misc[64 + lane] = pg::fsigm(bv);
        float c = zf;
#pragma unroll 8
        for (int m = 0; m < 64; ++m) { const float gm = misc[128 + m]; c += (m <= lane) ? gm : 0.f; }
        misc[lane] = c;
        wsp<float>(p, WS_CGG)[unit * 64 + (dir ? 63 - lane : lane)] = c;
    }
    stage_copy(t0, lane, GQ + ((size_t)1 * T + row_l) * 256 + h * 64);
    stage_copy(t1, lane, GQ + ((size_t)2 * T + row_l) * 256 + h * 64);
    unsigned vcol[32];
#pragma unroll
    for (int i = 0; i < 64; i += 2) vcol[i >> 1] = (unsigned)*(const LAS u16a*)(t1 + i * TS + lane * 2) | ((unsigned)*(const LAS u16a*)(t1 + (i + 1) * TS + lane * 2) << 16);
    {
        f32x4 acc[4][4]; mm64<true>(acc, t0, t0, lane);
#pragma unroll
        for (int mt = 0; mt < 4; ++mt) { const f32x4 cgm = *(const LAS f32x4*)(misc + 16 * mt + 4 * q), bem = *(const LAS f32x4*)(misc + 64 + 16 * mt + 4 * q);
#pragma unroll
            for (int nt = 0; nt < 4; ++nt) { const float cgn = misc[16 * nt + r];
#pragma unroll
                for (int g = 0; g < 4; ++g) { const int ii = 16 * mt + 4 * q + g, jj = 16 * nt + r; const float a = jj < ii ? bem[g] * acc[mt][nt][g] * ex2(cgm[g] - cgn) : 0.f;
                    *(LAS u16a*)(t1 + ii * TS + jj * 2) = f2bf(a); } } }
    }
    lane = relane();
    unsigned upk[32];
    {
        f32x2_t x[64];
        LAS const float* mp = misc; asm volatile("" : "+v"(mp));
#pragma unroll
        for (int i = 0; i < 64; ++i) { const float be = mp[64 + i];
            x[i].x = be * ex2(mp[i]) * bf2f(*(const LAS u16a*)(t0 + i * TS + lane * 2));
            x[i].y = be * __uint_as_float((i & 1) ? (vcol[i >> 1] & 0xffff0000u) : (vcol[i >> 1] << 16)); }
        solve2b_rows<1>(x, t1);
        lane = relane();
        {
            bf16_t* WN = wsp<bf16_t>(p, WS_WNG) + unit * 4096 + lane;
#pragma unroll
            for (int i = 0; i < 64; ++i) WN[(dir ? 63 - i : i) * 64] = f2bf(x[i].x);
#pragma unroll
            for (int c = 0; c < 8; ++c) { u32x4 w; w.x = cvt_pk_bf16(x[8 * c].x, x[8 * c + 1].x); w.y = cvt_pk_bf16(x[8 * c + 2].x, x[8 * c + 3].x); w.z = cvt_pk_bf16(x[8 * c + 4].x, x[8 * c + 5].x); w.w = cvt_pk_bf16(x[8 * c + 6].x, x[8 * c + 7].x);
                *(LAS u32x4*)(t0 + lane * TS + c * 16) = w; }
        }
        {
#pragma unroll
            for (int i = 0; i < 32; ++i) upk[i] = cvt_pk_bf16(x[2 * i].y, x[2 * i + 1].y);
            pg::u32x4* UT = (pg::u32x4*)(wsp<bf16_t>(p, WS_UTG) + unit * 4096 + lane * 64);
#pragma unroll
            for (int c = 0; c < 8; ++c) { pg::u32x4 w; w.x = upk[4 * c]; w.y = upk[4 * c + 1]; w.z = upk[4 * c + 2]; w.w = upk[4 * c + 3]; UT[c] = w; }
        }
    }
    lane = relane();
    const float cg63 = misc[63];
    stage_copy(t1, lane, GQ + ((size_t)1 * T + base + (dir ? 63 - lane : lane)) * 256 + h * 64);
    { auto fkt = [&](int i, float x) { return x * ex2(cg63 - misc[i]); }; transpose_inplace<false>(t1, lane, fkt); }
    {   f32x4 acc[4][4]; mm64<true>(acc, t0, t1, lane);
        const float ac = ex2(cg63); bf16_t* MC = wsp<bf16_t>(p, WS_MCG) + unit * 4096;
#pragma unroll
        for (int mt = 0; mt < 4; ++mt)
#pragma unroll
            for (int nt = 0; nt < 4; ++nt) { float e[4];
#pragma unroll
                for (int g = 0; g < 4; ++g) e[g] = ((16 * mt + 4 * q + g) == (16 * nt + r) ? ac : 0.f) - acc[mt][nt][g];
                pg::u32x2 w; w.x = cvt_pk_bf16(e[0], e[1]); w.y = cvt_pk_bf16(e[2], e[3]);
                *(pg::u32x2*)(MC + (16 * nt + r) * 64 + 32 * (mt >> 1) + 8 * q + 4 * (mt & 1)) = w; } }
#pragma unroll
    for (int c = 0; c < 8; ++c) { u32x4 w; w.x = upk[4 * c]; w.y = upk[4 * c + 1]; w.z = upk[4 * c + 2]; w.w = upk[4 * c + 3]; *(LAS u32x4*)(t0 + lane * TS + c * 16) = w; }
    {   f32x4 acc[4][4]; mm64<true>(acc, t1, t0, lane);
        float* BC = wsp<float>(p, WS_BCG) + unit * 4096;
#pragma unroll
        for (int mt = 0; mt < 4; ++mt)
#pragma unroll
            for (int nt = 0; nt < 4; ++nt) *(f32x4*)(BC + (16 * nt + r) * 64 + 16 * mt + 4 * q) = acc[mt][nt]; }
}
constexpr int GSZ = 13, NGRP = NCH / GSZ;
constexpr size_t WS_PGG = 494 * MiB, WS_RGG = 496 * MiB, WS_SGG = 499 * MiB;
static_assert(NGRP * GSZ == NCH, "groups");
DEV void scan_step(pg::bf16x8 (&sb)[2], const bf16_t* mrow  , const float* cin  ) {
    f32x4 c[4]; pg::bf16x8 a[4][2];
#pragma unroll
    for (int mt = 0; mt < 4; ++mt) { c[mt] = cin ? *(const f32x4*)(cin + 16 * mt) : (f32x4){0.f, 0.f, 0.f, 0.f};
#pragma unroll
        for (int ks = 0; ks < 2; ++ks) a[mt][ks] = *(const pg::bf16x8*)(mrow + 16 * mt * 64 + 32 * ks); }
#pragma unroll
    for (int mt = 0; mt < 4; ++mt) { c[mt] = __builtin_amdgcn_mfma_f32_16x16x32_bf16(a[mt][0], sb[0], c[mt], 0, 0, 0); c[mt] = __builtin_amdgcn_mfma_f32_16x16x32_bf16(a[mt][1], sb[1], c[mt], 0, 0, 0); }
#pragma unroll
    for (int ks = 0; ks < 2; ++ks) { pg::u32x4 w; w.x = cvt_pk_bf16(c[2 * ks][0], c[2 * ks][1]); w.y = cvt_pk_bf16(c[2 * ks][2], c[2 * ks][3]); w.z = cvt_pk_bf16(c[2 * ks + 1][0], c[2 * ks + 1][1]); w.w = cvt_pk_bf16(c[2 * ks + 1][2], c[2 * ks + 1][3]);
        sb[ks] = __builtin_bit_cast(pg::bf16x8, w); }
}
DEV void state_store(const pg::bf16x8 (&sb)[2], bf16_t* dst  ) {
#pragma unroll
    for (int mt = 0; mt < 4; ++mt) { const pg::u32x4 w = __builtin_bit_cast(pg::u32x4, sb[mt >> 1]); pg::u32x2 o; o.x = (mt & 1) ? w.z : w.x; o.y = (mt & 1) ? w.w : w.y; *(pg::u32x2*)(dst + 16 * mt) = o; }
}
DEV void state_load(pg::bf16x8 (&sb)[2], const bf16_t* src) {
#pragma unroll
    for (int ks = 0; ks < 2; ++ks) { const pg::u32x2 lo = *(const pg::u32x2*)(src + 32 * ks), hi = *(const pg::u32x2*)(src + 32 * ks + 16); pg::u32x4 w; w.x = lo.x; w.y = lo.y; w.z = hi.x; w.w = hi.y; sb[ks] = __builtin_bit_cast(pg::bf16x8, w); }
}
template <int N, int DEPTH, bool USEC = true, class F> DEV void scan_run(pg::bf16x8 (&sb)[2], const bf16_t* mrow, const float* cin, F&& before) {
    constexpr int S = DEPTH + 1;
    pg::bf16x8 a[S][4][2]; f32x4 c[S][4];
#define SCAN_LD(slot, t) do { _Pragma("unroll") for (int mt_ = 0; mt_ < 4; ++mt_) { if constexpr (USEC) c[slot][mt_] = *(const f32x4*)(cin + (size_t)(t) * 4096 + 16 * mt_); \
        _Pragma("unroll") for (int ks_ = 0; ks_ < 2; ++ks_) a[slot][mt_][ks_] = *(const pg::bf16x8*)(mrow + (size_t)(t) * 4096 + 16 * mt_ * 64 + 32 * ks_); } } while (0)
#pragma unroll
    for (int t = 0; t < DEPTH; ++t) if (t < N) SCAN_LD(t % S, t);
    __builtin_amdgcn_sched_barrier(0);
#pragma unroll
    for (int t = 0; t < N; ++t) {
        if (t + DEPTH < N) { SCAN_LD((t + DEPTH) % S, t + DEPTH); __builtin_amdgcn_sched_barrier(0); }
        before(t);
        const int sl = t % S; f32x4 cc[4];
#pragma unroll
        for (int mt = 0; mt < 4; ++mt) { cc[mt] = __builtin_amdgcn_mfma_f32_16x16x32_bf16(a[sl][mt][0], sb[0], USEC ? c[sl][mt] : (f32x4){0.f, 0.f, 0.f, 0.f}, 0, 0, 0); cc[mt] = __builtin_amdgcn_mfma_f32_16x16x32_bf16(a[sl][mt][1], sb[1], cc[mt], 0, 0, 0); }
#pragma unroll
        for (int ks = 0; ks < 2; ++ks) { pg::u32x4 w; w.x = cvt_pk_bf16(cc[2 * ks][0], cc[2 * ks][1]); w.y = cvt_pk_bf16(cc[2 * ks][2], cc[2 * ks][3]); w.z = cvt_pk_bf16(cc[2 * ks + 1][0], cc[2 * ks + 1][1]); w.w = cvt_pk_bf16(cc[2 * ks + 1][2], cc[2 * ks + 1][3]);
            sb[ks] = __builtin_bit_cast(pg::bf16x8, w); }
        __builtin_amdgcn_sched_barrier(0);
    }
#undef SCAN_LD
}
DEV void gdn_l1(const PV& p, int chain, int grp, int wave, int lane) {
    const int r = lane & 15, q = lane >> 4, isr = wave >> 2, col = (wave & 3) * 16 + r;
    const size_t u0 = (size_t)chain * NCH + grp * GSZ;
    const bf16_t* MC = wsp<bf16_t>(p, WS_MCG) + u0 * 4096 + r * 64 + 8 * q; const float* BC = wsp<float>(p, WS_BCG) + u0 * 4096 + col * 64 + 4 * q;
    pg::bf16x8 sb[2];
#pragma unroll
    for (int ks = 0; ks < 2; ++ks)
#pragma unroll
        for (int j = 0; j < 8; ++j) { const int row = 16 * (2 * ks + (j >> 2)) + 4 * q + (j & 3); sb[ks][j] = (short)((!isr && row == col) ? 0x3f80 : 0); }
    { auto nop = [](int) {};
      if (isr) scan_run<GSZ, 3, true>(sb, MC, BC, nop); else scan_run<GSZ, 3, false>(sb, MC, BC, nop); }
    const size_t g = (size_t)chain * NGRP + grp;
    if (isr) {
        float* RG = wsp<float>(p, WS_RGG) + g * 4096 + col * 64 + 4 * q;
#pragma unroll
        for (int mt = 0; mt < 4; ++mt) { const pg::u32x4 w = __builtin_bit_cast(pg::u32x4, sb[mt >> 1]); const unsigned w0 = (mt & 1) ? w.z : w.x, w1 = (mt & 1) ? w.w : w.y;
            *(f32x4*)(RG + 16 * mt) = (f32x4){__uint_as_float(w0 << 16), __uint_as_float(w0 & 0xffff0000u), __uint_as_float(w1 << 16), __uint_as_float(w1 & 0xffff0000u)}; }
    } else {
        bf16_t* PGm = wsp<bf16_t>(p, WS_PGG) + g * 4096; const int w4 = wave & 3, pic = 32 * (w4 >> 1) + 8 * (r >> 2) + 4 * (w4 & 1) + (r & 3);
#pragma unroll
        for (int ks = 0; ks < 2; ++ks)
#pragma unroll
            for (int j = 0; j < 8; ++j) { const int row = 16 * (2 * ks + (j >> 2)) + 4 * q + (j & 3); PGm[row * 64 + pic] = (bf16_t)sb[ks][j]; }
    }
}
template <bool ISR> DEV void l1_chain(pg::bf16x8 (&sb)[2], LAS const unsigned char* arow, const float* BC) {
    f32x4 cq[3][4];
    if constexpr (ISR) {
#pragma unroll
        for (int t = 0; t < 2; ++t)
#pragma unroll
            for (int mt = 0; mt < 4; ++mt) cq[t][mt] = *(const f32x4*)(BC + (size_t)t * 4096 + 16 * mt);
    }
#pragma unroll
    for (int t = 0; t < GSZ; ++t) {
        if constexpr (ISR) { if (t + 2 < GSZ) {
#pragma unroll
            for (int mt = 0; mt < 4; ++mt) cq[(t + 2) % 3][mt] = *(const f32x4*)(BC + (size_t)(t + 2) * 4096 + 16 * mt); } }
        f32x4 cc[4];
#pragma unroll
        for (int mt = 0; mt < 4; ++mt) { const bf16x8 a0 = *(const LAS bf16x8*)(arow + t * TILE_B + mt * 16 * TS), a1 = *(const LAS bf16x8*)(arow + t * TILE_B + mt * 16 * TS + 64);
            f32x4 c0; if constexpr (ISR) c0 = cq[t % 3][mt]; else c0 = (f32x4){0.f, 0.f, 0.f, 0.f};
            cc[mt] = __builtin_amdgcn_mfma_f32_16x16x32_bf16(__builtin_bit_cast(pg::bf16x8, a0), sb[0], c0, 0, 0, 0);
            cc[mt] = __builtin_amdgcn_mfma_f32_16x16x32_bf16(__builtin_bit_cast(pg::bf16x8, a1), sb[1], cc[mt], 0, 0, 0); }
#pragma unroll
        for (int ks = 0; ks < 2; ++ks) { pg::u32x4 w; w.x = cvt_pk_bf16(cc[2 * ks][0], cc[2 * ks][1]); w.y = cvt_pk_bf16(cc[2 * ks][2], cc[2 * ks][3]); w.z = cvt_pk_bf16(cc[2 * ks + 1][0], cc[2 * ks + 1][1]); w.w = cvt_pk_bf16(cc[2 * ks + 1][2], cc[2 * ks + 1][3]);
            sb[ks] = __builtin_bit_cast(pg::bf16x8, w); }
    }
}
DEV void gdn_l1_lds(const PV& p, int chain, int grp, int wave, int lane, LAS unsigned char* lds, int tid) {
    const int r = lane & 15, q = lane >> 4, isr = wave >> 2, col = (wave & 3) * 16 + r;
    const size_t u0 = (size_t)chain * NCH + grp * GSZ;
    {   const bf16_t* MCt = wsp<bf16_t>(p, WS_MCG) + u0 * 4096 + (tid >> 3) * 64 + (tid & 7) * 8;
        u32x4 w[GSZ];
#pragma unroll
        for (int k = 0; k < GSZ; ++k) w[k] = *(const u32x4*)(MCt + (size_t)k * 4096);
#pragma unroll
        for (int k = 0; k < GSZ; ++k) *(LAS u32x4*)(lds + k * TILE_B + (tid >> 3) * TS + (tid & 7) * 16) = w[k];
    }
    __syncthreads();
    const float* BC = wsp<float>(p, WS_BCG) + u0 * 4096 + col * 64 + 4 * q;
    pg::bf16x8 sb[2];
#pragma unroll
    for (int ks = 0; ks < 2; ++ks)
#pragma unroll
        for (int j = 0; j < 8; ++j) { const int row = 16 * (2 * ks + (j >> 2)) + 4 * q + (j & 3); sb[ks][j] = (short)((!isr && row == col) ? 0x3f80 : 0); }
    LAS const unsigned char* arow = lds + r * TS + q * 16;
    if (isr) l1_chain<true>(sb, arow, BC); else l1_chain<false>(sb, arow, BC);
    const size_t g = (size_t)chain * NGRP + grp;
    if (isr) {
        float* RG = wsp<float>(p, WS_RGG) + g * 4096 + col * 64 + 4 * q;
#pragma unroll
        for (int mt = 0; mt < 4; ++mt) { const pg::u32x4 w = __builtin_bit_cast(pg::u32x4, sb[mt >> 1]); const unsigned w0 = (mt & 1) ? w.z : w.x, w1 = (mt & 1) ? w.w : w.y;
            *(f32x4*)(RG + 16 * mt) = (f32x4){__uint_as_float(w0 << 16), __uint_as_float(w0 & 0xffff0000u), __uint_as_float(w1 << 16), __uint_as_float(w1 & 0xffff0000u)}; }
    } else {
        bf16_t* PGm = wsp<bf16_t>(p, WS_PGG) + g * 4096; const int w4 = wave & 3, pic = 32 * (w4 >> 1) + 8 * (r >> 2) + 4 * (w4 & 1) + (r & 3);
#pragma unroll
        for (int ks = 0; ks < 2; ++ks)
#pragma unroll
            for (int j = 0; j < 8; ++j) { const int row = 16 * (2 * ks + (j >> 2)) + 4 * q + (j & 3); PGm[row * 64 + pic] = (bf16_t)sb[ks][j]; }
    }
}
DEV void gdn_l2(const PV& p, int chain, int vg, int lane) {
    const int r = lane & 15, q = lane >> 4, col = vg * 16 + r; const size_t g0 = (size_t)chain * NGRP;
    const bf16_t* PGm = wsp<bf16_t>(p, WS_PGG) + g0 * 4096 + r * 64 + 8 * q; const float* RG = wsp<float>(p, WS_RGG) + g0 * 4096 + col * 64 + 4 * q;
    bf16_t* SG = wsp<bf16_t>(p, WS_SGG) + g0 * 4096 + col * 64 + 4 * q;
    pg::bf16x8 sb[2];
#pragma unroll
    for (int ks = 0; ks < 2; ++ks)
#pragma unroll
        for (int j = 0; j < 8; ++j) sb[ks][j] = (short)p.z;
#pragma unroll
    for (int g = 0; g < NGRP; ++g) { state_store(sb, SG + (size_t)g * 4096); if (g + 1 < NGRP) scan_step(sb, PGm + (size_t)g * 4096, RG + (size_t)g * 4096); }
}
DEV void gdn_l3(const PV& p, int chain, int grp, int vg, int lane) {
    const int r = lane & 15, q = lane >> 4, col = vg * 16 + r; const size_t u0 = (size_t)chain * NCH + grp * GSZ;
    const bf16_t* MC = wsp<bf16_t>(p, WS_MCG) + u0 * 4096 + r * 64 + 8 * q; const float* BC = wsp<float>(p, WS_BCG) + u0 * 4096 + col * 64 + 4 * q;
    bf16_t* SS = wsp<bf16_t>(p, WS_SSG) + u0 * 4096 + col * 64 + 4 * q;
    pg::bf16x8 sb[2]; state_load(sb, wsp<bf16_t>(p, WS_SGG) + ((size_t)chain * NGRP + grp) * 4096 + col * 64 + 4 * q);
#pragma unroll
    for (int t = 0; t < GSZ; ++t) { state_store(sb, SS + (size_t)t * 4096); if (t + 1 < GSZ) scan_step(sb, MC + (size_t)t * 4096, BC + (size_t)t * 4096); }
}
DEV void gdn_x3(const PV& p, const int l, int h, int cn, LAS unsigned char* wl, int lane, float* park  ) {
    asm volatile("" : "+v"(lane));
    const bf16_t* GQ = wsp<bf16_t>(p, WS_GQKV);
    const int nbase = cn < 4 ? 64 * cn : NC + 64 * (cn - 4); const int r = lane & 15, q = lane >> 4;
    LAS unsigned char* t0 = wl; LAS unsigned char* t1 = wl + TILE_B; LAS float* misc = (LAS float*)(wl + 2 * TILE_B);
    const int row_l = nbase + lane;
#pragma unroll 1
    for (int dir = 0; dir < 2; ++dir) {
        const size_t un = (size_t)(dir * 4 + h) * NCH + scan_index(dir, cn);
        misc[lane] = wsp<float>(p, WS_CGG)[un * 64 + lane];
        stage_copy(t0, lane, GQ + ((size_t)1 * T + row_l) * 256 + h * 64);
        stage_copy(t1, lane, GQ + ((size_t)0 * T + row_l) * 256 + h * 64);
        unsigned pk[4][4][2];
#pragma unroll
        for (int mh = 0; mh < 2; ++mh) { f32x4 acc[2][4]; mm32<true>(acc, t0, t1, lane, mh);
#pragma unroll
            for (int m2 = 0; m2 < 2; ++m2) { const int mt = 2 * mh + m2; const f32x4 cgm = *(const LAS f32x4*)(misc + 16 * mt + 4 * q);
#pragma unroll
                for (int nt = 0; nt < 4; ++nt) { const float cgn = misc[16 * nt + r]; float e[4];
#pragma unroll
                    for (int g = 0; g < 4; ++g) { const int jj = 16 * mt + 4 * q + g, ii = 16 * nt + r; const bool keep = dir ? (jj >= ii) : (jj <= ii); e[g] = keep ? acc[m2][nt][g] * ex2(cgn - cgm[g]) : 0.f; }
                    pk[mt][nt][0] = cvt_pk_bf16(e[0], e[1]); pk[mt][nt][1] = cvt_pk_bf16(e[2], e[3]); } } }
        stage_copy(t0, lane, wsp<bf16_t>(p, WS_SSG) + un * 4096 + lane * 64);
        stage_copy(t1, lane, wsp<bf16_t>(p, WS_WNG) + un * 4096 + lane * 64);
        unsigned dl[4][4][2];
        {   const bf16_t* UT = wsp<bf16_t>(p, WS_UTG) + un * 4096;
#pragma unroll
            for (int mh = 0; mh < 2; ++mh) { f32x4 acc[2][4]; mm32<true>(acc, t1, t0, lane, mh);
#pragma unroll
                for (int m2 = 0; m2 < 2; ++m2)
#pragma unroll
                    for (int nt = 0; nt < 4; ++nt) { const int mt = 2 * mh + m2;
                        const pg::u32x2 uu = *(const pg::u32x2*)(UT + (16 * nt + r) * 64 + (dir ? 60 - 16 * mt - 4 * q : 16 * mt + 4 * q));
                        const float u0 = dir ? __uint_as_float(uu.y & 0xffff0000u) : __uint_as_float(uu.x << 16), u1 = dir ? __uint_as_float(uu.y << 16) : __uint_as_float(uu.x & 0xffff0000u),
                                    u2 = dir ? __uint_as_float(uu.x & 0xffff0000u) : __uint_as_float(uu.y << 16), u3 = dir ? __uint_as_float(uu.x << 16) : __uint_as_float(uu.y & 0xffff0000u);
                        dl[mt][nt][0] = cvt_pk_bf16(u0 - acc[m2][nt][0], u1 - acc[m2][nt][1]); dl[mt][nt][1] = cvt_pk_bf16(u2 - acc[m2][nt][2], u3 - acc[m2][nt][3]); } } }
        stage_copy(t1, lane, GQ + ((size_t)0 * T + row_l) * 256 + h * 64);
        f32x4 accO[4][4]; mm64<true>(accO, t0, t1, lane);
#pragma unroll
        for (int nt = 0; nt < 4; ++nt) { const float f = ex2(misc[16 * nt + r]);
#pragma unroll
            for (int mt = 0; mt < 4; ++mt) accO[mt][nt] *= f; }
#pragma unroll
        for (int mt = 0; mt < 4; ++mt)
#pragma unroll
            for (int nt = 0; nt < 4; ++nt) { u32x2 w; w.x = dl[mt][nt][0]; w.y = dl[mt][nt][1]; *(LAS u32x2*)(t1 + (16 * nt + r) * TS + (16 * mt + 4 * q) * 2) = w;
                                             u32x2 w2; w2.x = pk[mt][nt][0]; w2.y = pk[mt][nt][1]; *(LAS u32x2*)(t0 + (16 * nt + r) * TS + (16 * mt + 4 * q) * 2) = w2; }
        mm64(accO, t1, t0, lane);
        if (dir == 0) {
            float* pl = park + lane * 64;
#pragma unroll
            for (int mt = 0; mt < 4; ++mt)
#pragma unroll
                for (int nt = 0; nt < 4; ++nt) *(f32x4*)(pl + (mt * 4 + nt) * 4) = accO[mt][nt];
        } else {
            const float* pp = park + lane * 64; asm volatile("" : "+v"(pp) : "v"(accO[3][3][3]));
#pragma unroll
            for (int mt = 0; mt < 4; ++mt)
#pragma unroll
                for (int nt = 0; nt < 4; ++nt) accO[mt][nt] += *(const f32x4*)(pp + (mt * 4 + nt) * 4);
            head_out(p, p.inp(I_GNG) + l * 64, accO, nbase, ZC_GG + h * 64, 768 + h * 64, lane);
        }
    }
}
}

DEV void ph_x1(const PV& p, const int l, int bid, int nb, LAS unsigned char* lds3) {
    const int lane = TIDX & 63, wave = p.wv; LAS unsigned char* wl = lds3 + wave * mx::WAVE_LDS;
    for (int u = bid * 8 + wave; u < 16 * mx::NCH; u += nb * 8) { const int chain = (u / mx::NCH) & 7, s = u % mx::NCH; if (u < 8 * mx::NCH) mx::ret_x1(p, chain >> 2, chain & 3, s, wl, lane); else mx::hg_x1(p, l, chain >> 2, chain & 3, s, wl, lane); }
}
DEV void ph_x1_gdn(const PV& p, const int l, int bid, int nb, LAS unsigned char* lds3) {
    const int wave = p.wv; LAS unsigned char* wl = lds3 + wave * mx::WAVE_LDS;
    const int nw = nb * 8, tot = 8 * mx::NCH;
    if (nw == 2048) {
        int v = bid * 8 + wave; if (v >= 1554) v += 6; if (v >= 1807) v += 13;
        const int chain = v / mx::NCH, s = v % mx::NCH; if (chain >> 2) mx::gdn_x1<1>(p, l, chain & 3, s, wl, mx::relane()); else mx::gdn_x1<0>(p, l, chain & 3, s, wl, mx::relane());
        return;
    }
    for (int k = 0; k < 2; ++k) {
        int u = -1;
        if (k == 0) u = bid * 8 + wave; else if (wave == 7 && nw + bid < tot) u = nw + bid;
        if (u < 0 || u >= tot) continue;
        const int chain = u / mx::NCH, s = u % mx::NCH; if (chain >> 2) mx::gdn_x1<1>(p, l, chain & 3, s, wl, mx::relane()); else mx::gdn_x1<0>(p, l, chain & 3, s, wl, mx::relane());
    }
    for (int u = nw + nb + bid * 8 + wave; u < tot; u += nw) {
        const int chain = u / mx::NCH, s = u % mx::NCH; if (chain >> 2) mx::gdn_x1<1>(p, l, chain & 3, s, wl, mx::relane()); else mx::gdn_x1<0>(p, l, chain & 3, s, wl, mx::relane());
    }
}
DEV void ph_x1_gdn_deferred(const PV& p, const int l, int bid, int nb, LAS unsigned char* lds3) {
    const int wave = p.wv; LAS unsigned char* wl = lds3 + wave * mx::WAVE_LDS;
    if (nb * 8 != 2048 || bid >= 32 || wave != 1) return;
    const int v = bid < 6 ? 1554 + bid : (bid < 19 ? 1807 + (bid - 6) : 2067 + (bid - 19));
    const int chain = v / mx::NCH, s = v % mx::NCH; if (chain >> 2) mx::gdn_x1<1>(p, l, chain & 3, s, wl, mx::relane()); else mx::gdn_x1<0>(p, l, chain & 3, s, wl, mx::relane());
}
DEV void ph_x2(const PV& p, const int l, int bid, int nb) {
    const int t = TIDX; if (t >= 256) return;
    const int gt = bid * 256 + t;
    if (gt < 8 * 4096) mx::ret_x2(p, gt); else if (gt < 16 * 4096) mx::hg_x2(p, gt - 8 * 4096);
}
DEV void ph_gdn_l1(const PV& p, int bid, int nb, LAS unsigned char* lds3) { const int tid = TIDX, lane = tid & 63;
    for (int u = bid; u < 8 * mx::NGRP; u += nb) { if (u % mx::NGRP != mx::NGRP - 1) { mx::gdn_l1_lds(p, u / mx::NGRP, u % mx::NGRP, p.wv, lane, lds3, tid); __syncthreads(); } } }
DEV void ph_gdn_l2(const PV& p, int bid, int nb) { if (p.wv == 0 && bid < 32) mx::gdn_l2(p, bid >> 2, bid & 3, TIDX & 63); }
DEV void ph_gdn_l3(const PV& p, int bid, int nb) { const int lane = TIDX & 63; for (int u = p.wv * nb + bid; u < 8 * mx::NGRP * 4; u += nb * 8) mx::gdn_l3(p, u / (mx::NGRP * 4), (u >> 2) % mx::NGRP, u & 3, lane); }
DEV void ph_x3_ret(const PV& p, const int l, int bid, int nb, LAS unsigned char* lds3, const int u0, const int u1, const int gw0, const int b0) {
    const int lane = TIDX & 63, wave = p.wv; LAS unsigned char* wl = lds3 + wave * mx::WAVE_LDS;
    if (b0 == -4) {
        int u = -1;
        if (wave >= 5) u = u0 + (wave - 5) * nb + bid; else if (wave == 4 && bid >= 16) u = u0 + 3 * nb + (bid - 16);
        if (u >= 0 && u < u1) mx::ret_x3(p, l, u / mx::NCH, u % mx::NCH, wl, lane);
        return; }
    if (b0 == -2) { for (int u = u0 + wave * nb + bid; u < u1; u += nb * 8) mx::ret_x3(p, l, u / mx::NCH, u % mx::NCH, wl, lane); return; }
    if (b0 < 0) { const int nw = nb * 8; int k = bid * 8 + wave - gw0; if (k < 0) k += nw;
        for (int u = u0 + k; u < u1; u += nw) mx::ret_x3(p, l, u / mx::NCH, u % mx::NCH, wl, lane); return; }
    if (bid < b0) return;
    const int nw = (nb - b0) * 8; const int k = wave * (nb - b0) + (bid - b0) - gw0; if (k < 0) return;
    for (int u = u0 + k; u < u1; u += nw) mx::ret_x3(p, l, u / mx::NCH, u % mx::NCH, wl, lane);
}
DEV void ph_x3_gdn(const PV& p, const int l, int bid, int nb, LAS unsigned char* lds3) {
    const int lane = TIDX & 63, wave = p.wv; LAS unsigned char* wl = lds3 + wave * mx::WAVE_LDS;
    float* park = wsp<float>(p, mx::WS_PARK) + (size_t)(bid * 8 + wave) * 4096;
    for (int u = wave * nb + bid; u < 4 * mx::NCH; u += nb * 8) mx::gdn_x3(p, l, u / mx::NCH, u % mx::NCH, wl, lane, park);
}
DEV void ph_x3_hg(const PV& p, const int l, int bid, int nb, LAS unsigned char* lds3, const int u0, const int u1, const int gw0, const int b0) {
    const int lane = TIDX & 63, wave = p.wv; LAS unsigned char* wl = lds3 + wave * mx::WAVE_LDS;
    float* park = wsp<float>(p, mx::WS_PARK2) + (size_t)(bid * 8 + wave) * 4096;
    if (bid < b0) return;
    const int nw = (nb - b0) * 8; const int k = wave * (nb - b0) + (bid - b0) - gw0; if (k < 0) return;
    for (int u = u0 + k; u < u1; u += nw) mx::hg_x3(p, l, u / mx::NCH, u % mx::NCH, wl, lane, park);
}

DEV void ph_topk_fast(const PV& p, const int l, int bid, int nb, LAS unsigned char* lds3) {
    const float* AFF = wsp<float>(p, WS_AFF); int* INV = wsp<int>(p, WS_INV); int* IDX = wsp<int>(p, WS_IDX); float* VAL = wsp<float>(p, WS_VAL);
    const int tid = TIDX, lane = tid & 63, wave = p.wv;
    LAS unsigned* hist = (LAS unsigned*)lds3;
    LAS unsigned* ctl = hist + 256;
    LAS unsigned* cnt = hist + 320;
    const int nunits = l == 0 ? 2 * NE : NE;
    for (int u = bid; u < nunits; u += nb) {
        const bool isctx = u >= NE; const int e = isctx ? u - NE : u;
        const int n = isctx ? NC : NL, cap = isctx ? CAP_C : CAP_L, rowbase = isctx ? 0 : NC, soff = isctx ? CAP_L : 0;
        const int tpt = isctx ? 1 : 32, t0 = tid * tpt; const bool act = t0 < n;
        unsigned v[32];
#pragma unroll
        for (int k = 0; k < 32; ++k) v[k] = (act && k < tpt) ? __float_as_uint(AFF[(size_t)(rowbase + t0 + k) * 16 + e]) : 0u;
        unsigned prefix = 0u, kth = (unsigned)cap;
#pragma unroll 1
        for (int shift = 24; shift >= 0; shift -= 8) {
            if (tid < 256) hist[tid] = 0u;
            __syncthreads();
            const unsigned himask = shift == 24 ? 0u : (0xffffffffu << (shift + 8));
#pragma unroll
            for (int k = 0; k < 32; ++k) if (act && k < tpt && (v[k] & himask) == prefix) __hip_atomic_fetch_add(&hist[(v[k] >> shift) & 255u], 1u, __ATOMIC_RELAXED, __HIP_MEMORY_SCOPE_WORKGROUP);
            __syncthreads();
            if (wave == 0) {
                const int g = 15 - (lane & 15); unsigned h[16], tot = 0u;
#pragma unroll
                for (int j = 0; j < 16; ++j) { h[j] = hist[16 * g + 15 - j]; tot += h[j]; }
                unsigned pre = 0u, run = tot;
                { unsigned t = USWZ(run, 0x041F); pre += (lane & 1) ? t : 0u; run += t; t = USWZ(run, 0x081F); pre += (lane & 2) ? t : 0u; run += t;
                  t = USWZ(run, 0x101F); pre += (lane & 4) ? t : 0u; run += t; t = USWZ(run, 0x201F); pre += (lane & 8) ? t : 0u; run += t; }
                unsigned cum = pre, bsel = 0u, rsel = 0u; bool found = !(pre < kth && kth <= pre + tot);
#pragma unroll
                for (int j = 0; j < 16; ++j) { const bool f = !found && cum + h[j] >= kth; bsel = f ? (unsigned)(16 * g + 15 - j) : bsel; rsel = f ? kth - cum : rsel; found = found || f; cum += found ? 0u : h[j]; }
                if (lane < 16 && pre < kth && kth <= pre + tot) { ctl[0] = bsel; ctl[1] = rsel; }
            }
            __syncthreads();
            prefix |= ctl[0] << shift; kth = ctl[1];
            __syncthreads();
        }
        const unsigned thr = prefix, need_eq = kth;
        unsigned cgt = 0u, ceq = 0u;
#pragma unroll
        for (int k = 0; k < 32; ++k) if (act && k < tpt) { cgt += v[k] > thr ? 1u : 0u; ceq += v[k] == thr ? 1u : 0u; }
        unsigned before = 0u;
        { unsigned run = cgt | (ceq << 16), t;
          t = USWZ(run, 0x041F); before += (lane & 1) ? t : 0u; run += t; t = USWZ(run, 0x081F); before += (lane & 2) ? t : 0u; run += t;
          t = USWZ(run, 0x101F); before += (lane & 4) ? t : 0u; run += t; t = USWZ(run, 0x201F); before += (lane & 8) ? t : 0u; run += t;
          t = USWZ(run, 0x401F); before += (lane & 16) ? t : 0u; run += t;
          const auto rr = __builtin_amdgcn_permlane32_swap(run, run, false, false); t = rr[0] + rr[1] - run; before += (lane & 32) ? t : 0u; run += t;
          if (lane == 63) cnt[512 + wave] = run; }
        __syncthreads();
        for (int w = 0; w < wave; ++w) before += cnt[512 + w];
        unsigned gtb = before & 0xffffu, eqb = before >> 16;
#pragma unroll
        for (int k = 0; k < 32; ++k) if (act && k < tpt) {
            const bool gt = v[k] > thr, eq = v[k] == thr; const bool sel = gt || (eq && eqb < need_eq);
            const int slot = soff + (int)(gtb + (eqb < need_eq ? eqb : need_eq)); const int row = rowbase + t0 + k;
            INV[(size_t)row * 16 + e] = sel ? slot : -1;
            if (sel) { IDX[e * EROWS + slot] = row; VAL[e * EROWS + slot] = __uint_as_float(v[k]); }
            gtb += gt ? 1u : 0u; eqb += eq ? 1u : 0u;
        }
        __syncthreads();
    }
    for (int idx = bid * NTHREADS_C + tid; idx < NE * (EROWS - CAP_L); idx += nb * NTHREADS_C) { const int e = idx / (EROWS - CAP_L), sl = CAP_L + idx % (EROWS - CAP_L);
        if (l != 0 || sl >= CAP_L + CAP_C) { IDX[e * EROWS + sl] = 0; VAL[e * EROWS + sl] = 0.f; } }
}

#define XB_TMO      128
#define XB_XCNT(j)  (256  + 64 * (j))
#define XB_XSUB(j)  (1280 + 64 * (j))
#define XB_XGEN(j)  (2304 + 64 * (j))
#define XB_TOP      3328
#define XB_TOPGEN   3392
#define XCD_BAR_WORDS 3456
#define XB_SPIN_CAP (1u << 18)

__device__ __forceinline__ unsigned xb_ld(unsigned* p)              { return __hip_atomic_load(p, __ATOMIC_RELAXED, __HIP_MEMORY_SCOPE_AGENT); }
__device__ __forceinline__ unsigned xb_add(unsigned* p, unsigned v) { return __hip_atomic_fetch_add(p, v, __ATOMIC_RELAXED, __HIP_MEMORY_SCOPE_AGENT); }
__device__ __forceinline__ unsigned xb_xcc_id() { return (unsigned)__builtin_amdgcn_s_getreg((3 << 11) | 20) & 0xFu; }
#define XB_SPIN(cond, bar) do { unsigned _sp = 0; while (cond) { __builtin_amdgcn_s_sleep(1); \
    if ((++_sp & 255u) == 0u) { if (xb_ld(&(bar)[XB_TMO])) break; if (_sp > XB_SPIN_CAP) { atomicAdd(&(bar)[XB_TMO], 1u); break; } } } } while (0)

struct XcdBarrier {
    unsigned* bar; unsigned x;
    volatile __attribute__((address_space(3))) unsigned* st;
};

__device__ __forceinline__ XcdBarrier xcd_barrier_post(unsigned* bar, volatile __attribute__((address_space(3))) unsigned* st) {
    XcdBarrier b; b.bar = bar; b.x = xb_xcc_id(); b.st = st;
    if (threadIdx.x == 0) (void)xb_add(&bar[XB_XCNT(b.x)], 1u);
    return b;
}
__device__ __forceinline__ void xcd_barrier_complete(unsigned* bar, unsigned x, unsigned& nloc, unsigned& nx) {
    const unsigned G = gridDim.x * gridDim.y * gridDim.z;
    unsigned sum, cnt, mine, sp = 0u;
    for (;;) {
        sum = 0u; cnt = 0u; mine = 0u;
#pragma unroll
        for (unsigned j = 0; j < 16; ++j) { const unsigned c = xb_ld(&bar[XB_XCNT(j)]); sum += c; cnt += (c > 0u) ? 1u : 0u; mine = (j == x) ? c : mine; }
        if (sum == G) break;
        __builtin_amdgcn_s_sleep(1);
        if ((++sp & 255u) == 0u) { if (xb_ld(&bar[XB_TMO])) break; if (sp > XB_SPIN_CAP) { atomicAdd(&bar[XB_TMO], 1u); break; } }
    }
    nloc = mine > 0u ? mine : 1u; nx = cnt > 0u ? cnt : 1u;
}

__device__ __forceinline__ void xcd_barrier(const XcdBarrier& b) {
    asm volatile("s_waitcnt vmcnt(0)" ::: "memory");
    __syncthreads();
    if (threadIdx.x == 0) {
        unsigned* bar = b.bar;
        __builtin_amdgcn_s_waitcnt(0);
        unsigned nloc = b.st[0], nx = b.st[1];
        if (nloc == 0u) { xcd_barrier_complete(bar, b.x, nloc, nx); b.st[0] = nloc; b.st[1] = nx; }
        const unsigned old = xb_add(&bar[XB_XSUB(b.x)], 1u);
        const unsigned gen = old / nloc;
        if (old + 1u == (gen + 1u) * nloc) {
            __builtin_amdgcn_fence(__ATOMIC_RELEASE, "agent");
            asm volatile("s_waitcnt vmcnt(0)" ::: "memory");
            const unsigned og = xb_add(&bar[XB_TOP], 1u);
            const unsigned tg = og / nx;
            if (og + 1u == (tg + 1u) * nx) xb_add(&bar[XB_TOPGEN], 1u);
            else XB_SPIN(xb_ld(&bar[XB_TOPGEN]) == tg, bar);
            __builtin_amdgcn_fence(__ATOMIC_ACQUIRE, "agent");
            xb_add(&bar[XB_XGEN(b.x)], 1u);
            asm volatile("s_waitcnt vmcnt(0)" ::: "memory");
        } else {
            XB_SPIN(xb_ld(&bar[XB_XGEN(b.x)]) == gen, bar);
            __builtin_amdgcn_fence(__ATOMIC_ACQUIRE, "agent");
            asm volatile("s_waitcnt vmcnt(0)" ::: "memory");
        }
    }
    __syncthreads();
}


DEV unsigned opaque_zero() { unsigned z; asm volatile("s_mov_b32 %0, 0" : "=s"(z)); return z; }
DEV void xbar_sync(const XcdBarrier& b) { XcdBarrier c = b; const unsigned z = opaque_zero(); c.bar = b.bar + z; c.x = b.x + z; xcd_barrier(c); }
constexpr int NTHREADS = 512;
constexpr int LDS_MIX = 8 * 19456, LDS_BYTES = LDS_MIX + 64;
__global__ void __launch_bounds__(NTHREADS) mega_fwd(P p) {
    extern __shared__ __attribute__((aligned(16))) unsigned char smem[];
    LAS unsigned char* lds3 = (LAS unsigned char*)smem;
    const int wv_ = __builtin_amdgcn_readfirstlane((int)(threadIdx.x >> 6));
    if (threadIdx.x < 16) ((LAS unsigned*)(lds3 + LDS_MIX))[threadIdx.x] = 0u;
    __syncthreads();
    const XcdBarrier xbar = xcd_barrier_post((unsigned*)p.ws, (volatile LAS unsigned*)(lds3 + LDS_MIX));
        { const PV q{p, opaque_zero(), wv_}; const int bid = blockIdx.x + q.z, nb = gridDim.x + q.z; ph_prologue(q, 0, bid, nb, lds3); }
    xbar_sync(xbar);
    for (int l = 0; l < 2; ++l) {
        if (l == 0) {
        { const PV q{p, opaque_zero(), wv_}; const int bid = blockIdx.x + q.z, nb = gridDim.x + q.z; ph_rows0(q, 0, bid, nb, lds3); }
        __syncthreads();
        { const PV q{p, opaque_zero(), wv_}; const int bid = blockIdx.x + q.z, nb = gridDim.x + q.z; ph_wconv(q, 0, bid, nb, lds3, 0); }            xbar_sync(xbar);
        }
        { const PV q{p, opaque_zero(), wv_}; const int bid = blockIdx.x + q.z, nb = gridDim.x + q.z; ph_g1_fast(q, bid, nb, lds3); }          xbar_sync(xbar);
        { const PV q{p, opaque_zero(), wv_}; const int bid = blockIdx.x + q.z, nb = gridDim.x + q.z; ph_mixprep(q, l, bid, nb); }
        { const PV q{p, opaque_zero(), wv_}; const int bid = blockIdx.x + q.z, nb = gridDim.x + q.z; ph_x1(q, l, bid, nb, lds3); }          xbar_sync(xbar);
        { const PV q{p, opaque_zero(), wv_}; const int bid = blockIdx.x + q.z, nb = gridDim.x + q.z; ph_x2(q, l, bid, nb); }
        { const PV q{p, opaque_zero(), wv_}; const int bid = blockIdx.x + q.z, nb = gridDim.x + q.z; ph_x1_gdn(q, l, bid, nb, lds3); }          xbar_sync(xbar);
        { const PV q{p, opaque_zero(), wv_}; const int bid = blockIdx.x + q.z, nb = gridDim.x + q.z; ph_gdn_l1(q, bid, nb, lds3); }
        xbar_sync(xbar);
        { const PV q{p, opaque_zero(), wv_}; const int bid = blockIdx.x + q.z, nb = gridDim.x + q.z; ph_gdn_l2(q, bid, nb); }
        { const PV q{p, opaque_zero(), wv_}; const int bid = blockIdx.x + q.z, nb = gridDim.x + q.z; ph_x1_gdn_deferred(q, l, bid, nb, lds3); }
        { const PV q{p, opaque_zero(), wv_}; const int bid = blockIdx.x + q.z, nb = gridDim.x + q.z; ph_x3_ret(q, l, bid, nb, lds3, 4 * mx::NCH - 32, 4 * mx::NCH, 4 * mx::NCH, 32); }
        { const PV q{p, opaque_zero(), wv_}; const int bid = blockIdx.x + q.z, nb = gridDim.x + q.z; ph_x3_hg(q, l, bid, nb, lds3, 0, 4 * mx::NCH, 0, 32); }          xbar_sync(xbar);
        { const PV q{p, opaque_zero(), wv_}; const int bid = blockIdx.x + q.z, nb = gridDim.x + q.z; ph_gdn_l3(q, bid, nb); }
        __syncthreads();
        { const PV q{p, opaque_zero(), wv_}; const int bid = blockIdx.x + q.z, nb = gridDim.x + q.z; ph_attn_fast(q, l, bid, nb, smem); }  xbar_sync(xbar);
        { const PV q{p, opaque_zero(), wv_}; const int bid = blockIdx.x + q.z, nb = gridDim.x + q.z; ph_x3_gdn(q, l, bid, nb, lds3); }
        { const PV q{p, opaque_zero(), wv_}; const int bid = blockIdx.x + q.z, nb = gridDim.x + q.z; ph_x3_ret(q, l, bid, nb, lds3, 0, 4 * mx::NCH - 32, 0, -4); }         xbar_sync(xbar);
        { const PV q{p, opaque_zero(), wv_}; const int bid = blockIdx.x + q.z, nb = gridDim.x + q.z; ph_g2_fast(q, l, bid, nb, lds3); }          xbar_sync(xbar);
        { const PV q{p, opaque_zero(), wv_}; const int bid = blockIdx.x + q.z, nb = gridDim.x + q.z; ph_g3_fast(q, l, bid, nb, lds3); }          xbar_sync(xbar);
        { const PV q{p, opaque_zero(), wv_}; const int bid = blockIdx.x + q.z, nb = gridDim.x + q.z; ph_g4_fast(q, l, bid, nb, lds3); }          xbar_sync(xbar);
        { const PV q{p, opaque_zero(), wv_}; const int bid = blockIdx.x + q.z, nb = gridDim.x + q.z; ph_rows1(q, l, bid, nb, lds3); }            xbar_sync(xbar);
        { const PV q{p, opaque_zero(), wv_}; const int bid = blockIdx.x + q.z, nb = gridDim.x + q.z; ph_topk_fast(q, l, bid, nb, lds3); }
        __syncthreads();
        { const PV q{p, opaque_zero(), wv_}; const int bid = blockIdx.x + q.z, nb = gridDim.x + q.z; ph_wconv(q, l, bid, nb, lds3, 1); }  xbar_sync(xbar);
        { const PV q{p, opaque_zero(), wv_}; const int bid = blockIdx.x + q.z, nb = gridDim.x + q.z; ph_g5_fast(q, l, bid, nb, lds3); }     xbar_sync(xbar);
        { const PV q{p, opaque_zero(), wv_}; const int bid = blockIdx.x + q.z, nb = gridDim.x + q.z; ph_g6_fast(q, l, bid, nb, lds3); }    xbar_sync(xbar);
        { const PV q{p, opaque_zero(), wv_}; const int bid = blockIdx.x + q.z, nb = gridDim.x + q.z; ph_rows2(q, l, bid, nb, lds3); }
        if (l == 0) {
        __syncthreads();
        { const PV q{p, opaque_zero(), wv_}; const int bid = blockIdx.x + q.z, nb = gridDim.x + q.z; ph_wconv(q, 1, bid, nb, lds3, 0); }            xbar_sync(xbar);
        }
    }
}

extern "C" void kernel_launch(void* const* d_in, const int* in_sizes, int n_in, void* d_out, int out_size, void* d_ws, size_t ws_size, hipStream_t stream) {
    if (n_in != N_IN || ws_size < WS_END || out_size != NL * D) { fprintf(stderr, "kernel_launch: unexpected sizes n_in %d ws %zu out %d\n", n_in, ws_size, out_size); return; }
    static int grid_blocks = 0;
    if (!grid_blocks) {
        int dev = 0, cus = 0, per_cu = 0;
        (void)hipGetDevice(&dev);
        (void)hipDeviceGetAttribute(&cus, hipDeviceAttributeMultiprocessorCount, dev);
        (void)hipFuncSetAttribute((const void*)mega_fwd, hipFuncAttributeMaxDynamicSharedMemorySize, LDS_BYTES);
        (void)hipOccupancyMaxActiveBlocksPerMultiprocessor(&per_cu, (const void*)mega_fwd, NTHREADS, LDS_BYTES);
        if (per_cu < 1) { fprintf(stderr, "kernel_launch: occupancy query says %d blocks/CU\n", per_cu); per_cu = 1; }
        if (per_cu > 1) per_cu = 1;
        grid_blocks = cus * per_cu;
    }
    (void)hipMemsetAsync(d_ws, 0, 65536, stream);
    P p{};
    for (int i = 0; i < N_IN; ++i) p.in[i] = (const float*)d_in[i];
    p.out = (float*)d_out; p.ws = (unsigned char*)d_ws;
    void* args[] = {&p};
    hipError_t e = hipLaunchCooperativeKernel((const void*)mega_fwd, dim3(grid_blocks), dim3(NTHREADS), args, LDS_BYTES, stream);
    if (e != hipSuccess) fprintf(stderr, "cooperative launch failed: %s (grid %d)\n", hipGetErrorString(e), grid_blocks);
}
```
